# Optimizing an MI355X kernel written in HIP

```python
import math, functools
import jax, jax.numpy as jnp
from jax import lax
import numpy as np

D_MODEL = 1024
BATCH = 8
SEQ = 2048
DEPTH = 1
DEC_BATCH = 128
DEC_SEQ = 4
PAST_LEN = 2048
PAGE_SIZE = 128

D_SSM = D_MODEL // 2
D_ATTN = D_MODEL // 2
D_MIX = D_SSM + D_ATTN
SSM_GROUP = 16
N_SSM_GROUPS = D_SSM // SSM_GROUP
SSM_STATE = 64
HEAD_DIM = 64
N_HEADS = D_ATTN // HEAD_DIM
DILATED_PATTERNS = ((128, 1), (512, 4), (2048, 16))
WINDOW_MAX = 2048
BAND_BLOCK = 128
D_IN_PROJ = 2 * D_SSM + 4 * D_ATTN
RMS_EPS = 1e-6
DT_MIN = 1e-3
DT_MAX = 1e-1

kernel_name = "hymba_s5_longnet_decode_step"


def _rmsnorm(x, g):
    xf = x.astype(jnp.float32)
    xf = xf * lax.rsqrt(jnp.mean(xf * xf, axis=-1, keepdims=True) + RMS_EPS)
    return (xf * g.astype(jnp.float32)).astype(x.dtype)


def _complex_affine_combine(e1, e2):
    ar1, ai1, br1, bi1 = e1
    ar2, ai2, br2, bi2 = e2
    ar = ar2 * ar1 - ai2 * ai1
    ai = ar2 * ai1 + ai2 * ar1
    br = ar2 * br1 - ai2 * bi1 + br2
    bi = ar2 * bi1 + ai2 * br1 + bi2
    return ar, ai, br, bi


def _s5_scan(u, h0_re, h0_im, A_re, A_im, log_dt, B_re, B_im, C_re, C_im, D):
    f32 = jnp.float32
    n_, t_ = u.shape[0], u.shape[1]
    u = u.astype(f32).reshape(n_, t_, N_SSM_GROUPS, SSM_GROUP)
    A_re = A_re.astype(f32)
    A_im = A_im.astype(f32)
    dt = jnp.exp(log_dt.astype(f32))[:, None]
    mag = jnp.exp(A_re * dt)
    ang = A_im * dt
    lam_re = mag * jnp.cos(ang)
    lam_im = mag * jnp.sin(ang)
    den = A_re * A_re + A_im * A_im
    f_re = ((lam_re - 1.0) * A_re + lam_im * A_im) / den
    f_im = (lam_im * A_re - (lam_re - 1.0) * A_im) / den
    B_re = B_re.astype(f32)
    B_im = B_im.astype(f32)
    Bb_re = f_re[..., None] * B_re - f_im[..., None] * B_im
    Bb_im = f_re[..., None] * B_im + f_im[..., None] * B_re
    bu_re = jnp.einsum('btgc,gpc->btgp', u, Bb_re)
    bu_im = jnp.einsum('btgc,gpc->btgp', u, Bb_im)
    h0_re = h0_re.astype(f32)
    h0_im = h0_im.astype(f32)
    bu_re = bu_re.at[:, 0].add(lam_re * h0_re - lam_im * h0_im)
    bu_im = bu_im.at[:, 0].add(lam_re * h0_im + lam_im * h0_re)
    a_re = jnp.broadcast_to(lam_re, bu_re.shape)
    a_im = jnp.broadcast_to(lam_im, bu_im.shape)
    _, _, x_re, x_im = lax.associative_scan(_complex_affine_combine, (a_re, a_im, bu_re, bu_im), axis=1)
    y = (jnp.einsum('btgp,gcp->btgc', x_re, C_re.astype(f32))
         - jnp.einsum('btgp,gcp->btgc', x_im, C_im.astype(f32))
         + D.astype(f32).reshape(N_SSM_GROUPS, SSM_GROUP) * u)
    return y.reshape(n_, t_, D_SSM), x_re[:, -1], x_im[:, -1]


def _dilated_band(q, k, v, window, dil):
    b_, s_, h_, e_ = q.shape
    n = s_ // dil
    nb = -(-n // BAND_BLOCK)
    npad = nb * BAND_BLOCK
    reach = window // dil

    def to_blocks(t):
        t = t.reshape(b_, n, dil, h_, e_).transpose(0, 2, 1, 3, 4)
        t = jnp.pad(t, ((0, 0), (0, 0), (0, npad - n), (0, 0), (0, 0)))
        return t.reshape(b_, dil, nb, BAND_BLOCK, h_, e_)

    def with_prev(t):
        prev = jnp.pad(t[:, :, :-1], ((0, 0), (0, 0), (1, 0), (0, 0), (0, 0), (0, 0)))
        return jnp.concatenate([prev, t], axis=3)

    qb = to_blocks(q)
    kk = with_prev(to_blocks(k))
    vv = with_prev(to_blocks(v))
    s = jnp.einsum('brnqhe,brnkhe->brnhqk', qb, kk) * (HEAD_DIM ** -0.5)
    qi = jnp.arange(BAND_BLOCK)[None, :, None]
    ki = jnp.arange(2 * BAND_BLOCK)[None, None, :]
    blk = jnp.arange(nb)[:, None, None]
    dist = qi + BAND_BLOCK - ki
    u_k = blk * BAND_BLOCK - BAND_BLOCK + ki
    valid = (dist >= 0) & (dist <= reach) & (u_k >= 0)
    s = jnp.where(valid[None, None, :, None], s, -jnp.inf)
    m = jnp.max(s, axis=-1)
    p = jnp.exp(s - m[..., None])
    l = jnp.sum(p, axis=-1)
    o = jnp.einsum('brnhqk,brnkhe->brnqhe', p, vv)
    o = o.reshape(b_, dil, npad, h_, e_)[:, :, :n].transpose(0, 2, 1, 3, 4).reshape(b_, s_, h_, e_)

    def stat_back(t):
        t = t.transpose(0, 1, 2, 4, 3).reshape(b_, dil, npad, h_)[:, :, :n]
        return t.transpose(0, 2, 1, 3).reshape(b_, s_, h_)

    return o, stat_back(m), stat_back(l)


def _dilated_gather(q, k_all, v_all, window, dil):
    t_ = q.shape[1]
    l_ = k_all.shape[1]
    offs = jnp.arange(window // dil + 1) * dil
    idx = (l_ - t_ + jnp.arange(t_))[:, None] - offs[None, :]
    valid = idx >= 0
    idx_c = jnp.clip(idx, 0, l_ - 1)
    kg = k_all[:, idx_c]
    vg = v_all[:, idx_c]
    s = jnp.einsum('bthe,btkhe->bhtk', q, kg) * (HEAD_DIM ** -0.5)
    s = jnp.where(valid[None, None], s, -jnp.inf)
    m = jnp.max(s, axis=-1)
    p = jnp.exp(s - m[..., None])
    l = jnp.sum(p, axis=-1)
    o = jnp.einsum('bhtk,btkhe->bthe', p, vg)
    return o, m.transpose(0, 2, 1), l.transpose(0, 2, 1)


def _combine(parts):
    big_m = functools.reduce(jnp.maximum, [m for _, m, _ in parts])
    ws = [jnp.exp(m - big_m) for _, m, _ in parts]
    num = functools.reduce(jnp.add, [w[..., None] * o for w, (o, _, _) in zip(ws, parts)])
    den = functools.reduce(jnp.add, [w * l for w, (_, _, l) in zip(ws, parts)])
    return num / den[..., None]


def _prompt_attention(q, k, v):
    return _combine([_dilated_band(q, k, v, w, d) for w, d in DILATED_PATTERNS])


def _sample_attention(q, k, v, k_past, v_past):
    k_all = jnp.concatenate([k_past.astype(jnp.float32), k], axis=1)
    v_all = jnp.concatenate([v_past.astype(jnp.float32), v], axis=1)
    return _combine([_dilated_gather(q, k_all, v_all, w, d) for w, d in DILATED_PATTERNS])


def _layer(h, h0_re, h0_im, attend, norm_in_g, w_in, A_re, A_im, log_dt, B_re, B_im, C_re, C_im, D,
           w_glu, b_glu, norm_ssm_g, norm_attn_g, w_out):
    n_, t_ = h.shape[0], h.shape[1]
    proj = _rmsnorm(h, norm_in_g) @ w_in
    o1 = D_SSM
    o2 = o1 + D_SSM
    o3 = o2 + D_ATTN
    o4 = o3 + D_ATTN
    o5 = o4 + D_ATTN
    x_s, z_s = proj[..., :o1], proj[..., o1:o2]
    q, k, v, z_a = proj[..., o2:o3], proj[..., o3:o4], proj[..., o4:o5], proj[..., o5:]
    y_s, st_re, st_im = _s5_scan(x_s, h0_re, h0_im, A_re, A_im, log_dt, B_re, B_im, C_re, C_im, D)
    g = jax.nn.gelu(y_s)
    gl = g @ w_glu.astype(jnp.float32) + b_glu.astype(jnp.float32)
    y_s = gl[..., :D_SSM] * jax.nn.sigmoid(gl[..., D_SSM:])
    y_s = (y_s * jax.nn.silu(z_s.astype(jnp.float32))).astype(h.dtype)
    y_s = _rmsnorm(y_s, norm_ssm_g)
    qh = q.astype(jnp.float32).reshape(n_, t_, N_HEADS, HEAD_DIM)
    kh = k.astype(jnp.float32).reshape(n_, t_, N_HEADS, HEAD_DIM)
    vh = v.astype(jnp.float32).reshape(n_, t_, N_HEADS, HEAD_DIM)
    y_a = attend(qh, kh, vh).reshape(n_, t_, D_ATTN)
    y_a = (y_a * jax.nn.silu(z_a.astype(jnp.float32))).astype(h.dtype)
    y_a = _rmsnorm(y_a, norm_attn_g)
    out = jnp.concatenate([y_s, y_a], axis=-1) @ w_out
    return (h + out).astype(h.dtype), kh.astype(h.dtype), vh.astype(h.dtype), st_re, st_im


def setup_inputs(seed: int = 0) -> dict:
    key = jax.random.key(seed)
    ks = jax.random.split(key, 24)
    f32 = jnp.float32
    wbuf = min(WINDOW_MAX, PAST_LEN)
    nrm = lambda k, shp: jax.random.normal(k, shp, f32)
    return {
        "x_prompt": nrm(ks[0], (BATCH, SEQ, D_MODEL)),
        "x_sample": nrm(ks[1], (DEC_BATCH, DEC_SEQ, D_MODEL)),
        "cache_k": nrm(ks[2], (DEPTH, DEC_BATCH, wbuf, N_HEADS, HEAD_DIM)),
        "cache_v": nrm(ks[3], (DEPTH, DEC_BATCH, wbuf, N_HEADS, HEAD_DIM)),
        "state_ssm_re": 0.3 * nrm(ks[4], (DEPTH, DEC_BATCH, N_SSM_GROUPS, SSM_STATE)),
        "state_ssm_im": 0.3 * nrm(ks[5], (DEPTH, DEC_BATCH, N_SSM_GROUPS, SSM_STATE)),
        "norm_in_g": 1.0 + 0.02 * nrm(ks[6], (DEPTH, D_MODEL)),
        "w_in": nrm(ks[7], (DEPTH, D_MODEL, D_IN_PROJ)) * D_MODEL ** -0.5,
        "ssm_A_re": -0.5 + 0.01 * nrm(ks[8], (DEPTH, N_SSM_GROUPS, SSM_STATE)),
        "ssm_A_im": math.pi * jnp.arange(SSM_STATE, dtype=f32) + 0.01 * nrm(ks[9], (DEPTH, N_SSM_GROUPS, SSM_STATE)),
        "ssm_log_dt": jax.random.uniform(ks[10], (DEPTH, N_SSM_GROUPS), f32, math.log(DT_MIN), math.log(DT_MAX)),
        "ssm_B_re": nrm(ks[11], (DEPTH, N_SSM_GROUPS, SSM_STATE, SSM_GROUP)) * (2 * SSM_GROUP) ** -0.5,
        "ssm_B_im": nrm(ks[12], (DEPTH, N_SSM_GROUPS, SSM_STATE, SSM_GROUP)) * (2 * SSM_GROUP) ** -0.5,
        "ssm_C_re": nrm(ks[13], (DEPTH, N_SSM_GROUPS, SSM_GROUP, SSM_STATE)) * SSM_STATE ** -0.5,
        "ssm_C_im": nrm(ks[14], (DEPTH, N_SSM_GROUPS, SSM_GROUP, SSM_STATE)) * SSM_STATE ** -0.5,
        "ssm_D": nrm(ks[15], (DEPTH, D_SSM)),
        "w_glu": nrm(ks[16], (DEPTH, D_SSM, 2 * D_SSM)) * D_SSM ** -0.5,
        "b_glu": 0.01 * nrm(ks[17], (DEPTH, 2 * D_SSM)),
        "norm_ssm_g": 1.0 + 0.02 * nrm(ks[18], (DEPTH, D_SSM)),
        "norm_attn_g": 1.0 + 0.02 * nrm(ks[19], (DEPTH, D_ATTN)),
        "w_out": nrm(ks[20], (DEPTH, D_MIX, D_MODEL)) * D_MIX ** -0.5,
        "final_norm_g": 1.0 + 0.02 * nrm(ks[21], (D_MODEL,)),
    }


def reference(x_prompt, x_sample, cache_k, cache_v, state_ssm_re, state_ssm_im, norm_in_g, w_in,
              ssm_A_re, ssm_A_im, ssm_log_dt, ssm_B_re, ssm_B_im, ssm_C_re, ssm_C_im, ssm_D,
              w_glu, b_glu, norm_ssm_g, norm_attn_g, w_out, final_norm_g):
    hp, hs = x_prompt, x_sample
    wbuf_p = min(WINDOW_MAX, x_prompt.shape[1])
    kp_l, vp_l, rp_l, ip_l = [], [], [], []
    ks_l, vs_l, rs_l, is_l = [], [], [], []
    zero_state = jnp.zeros((x_prompt.shape[0], N_SSM_GROUPS, SSM_STATE), jnp.float32)
    for l in range(DEPTH):
        params = (norm_in_g[l], w_in[l], ssm_A_re[l], ssm_A_im[l], ssm_log_dt[l], ssm_B_re[l], ssm_B_im[l],
                  ssm_C_re[l], ssm_C_im[l], ssm_D[l], w_glu[l], b_glu[l], norm_ssm_g[l], norm_attn_g[l], w_out[l])
        hp, kp, vp, rp, ip = _layer(hp, zero_state, zero_state, _prompt_attention, *params)
        attend_s = functools.partial(_sample_attention, k_past=cache_k[l], v_past=cache_v[l])
        hs, kn, vn, rs, is_ = _layer(hs, state_ssm_re[l], state_ssm_im[l], attend_s, *params)
        kp_l.append(kp[:, -wbuf_p:])
        vp_l.append(vp[:, -wbuf_p:])
        rp_l.append(rp)
        ip_l.append(ip)
        ks_l.append(kn)
        vs_l.append(vn)
        rs_l.append(rs)
        is_l.append(is_)
    y_prompt = _rmsnorm(hp, final_norm_g)
    y_sample = _rmsnorm(hs, final_norm_g)
    return (y_prompt, y_sample,
            jnp.stack(kp_l), jnp.stack(vp_l), jnp.stack(rp_l), jnp.stack(ip_l),
            jnp.stack(ks_l), jnp.stack(vs_l), jnp.stack(rs_l), jnp.stack(is_l))
```

```cpp
#include <hip/hip_runtime.h>
#include <cstdio>
#include <cstdint>
constexpr size_t O_YP = 0, O_YS = 16777216, O_KP = 17301504, O_VP = 25690112, O_RP = 34078720, O_IP = 34095104,
                 O_KS = 34111488, O_VS = 34373632, O_RS = 34635776, O_IS = 34897920, O_END = 35160064;
constexpr int MP = 16384, MS = 512, MT = MP + MS;
constexpr int DM = 1024, NPROJ = 3072;
namespace pg8 {
#define PG8_LAS __attribute__((address_space(3)))
typedef unsigned short bf16_t;
typedef short bf16x8 __attribute__((ext_vector_type(8)));
typedef float f32x4 __attribute__((ext_vector_type(4)));
typedef unsigned u32x4 __attribute__((ext_vector_type(4)));
constexpr int BM = 256, BK = 64, HALF = 128, HTB = HALF * BK * 2  , STAGE_BYTES = 8 * HTB, NXCD = 8, WGM = 8;

__host__ __device__ __forceinline__ int lds_byte(int r, int c) { const int st = (r >> 4) * 2 + (c >> 5), rr = r & 15, cc = c & 31, ob = rr * 64 + cc * 2; return st * 1024 + (ob ^ (((ob >> 9) & 1) << 5)); }
__host__ __device__ __forceinline__ void stage_rc(int b, int& R, int& C) { const int st = b / 1024, sb = b % 1024, swz = sb ^ (((sb >> 9) & 1) << 5); R = (st >> 1) * 16 + swz / 64; C = (st & 1) * 32 + (swz % 64) / 2; }
__host__ __device__ __forceinline__ int perm32(int rho) { const int n = rho >> 4, i = rho & 15; return 8 * (i >> 2) + 4 * n + (i & 3); }

struct Unit { int pm, pn; };
struct Gemm { const bf16_t* A; const bf16_t* Bt; int M, N, K; };

struct StaticOrder {
    int nM, nN, nwg, G, c;
    __host__ __device__ void init(int M, int N, int G_, int c_) { nM = M / BM; nN = N / BM; nwg = nM * nN; G = G_; c = c_; }
    __host__ __device__ bool next(int i, Unit& u) const {
        const long L = (long)i * G + c; if (L >= nwg) return false;
        int wgid = (int)L; { const int q = nwg / NXCD, r = nwg % NXCD, xcd = wgid % NXCD, off = wgid / NXCD; wgid = (xcd < r ? xcd * (q + 1) : r * (q + 1) + (xcd - r) * q) + off; }
        const int nig = WGM * nN, gid = wgid / nig, fm = gid * WGM, gsz = (nM - fm) < WGM ? (nM - fm) : WGM;
        u.pm = fm + ((wgid % nig) % gsz); u.pn = (wgid % nig) / gsz; return true;
    }
    __device__ __forceinline__ void a_ready(const Unit&) const {}
    __device__ __forceinline__ void done(const Unit&) const {}
};

__device__ __forceinline__ unsigned cvt_pk_bf16(float lo, float hi) { unsigned r; asm volatile("v_cvt_pk_bf16_f32 %0, %1, %2" : "=v"(r) : "v"(lo), "v"(hi)); return r; }
typedef float f32x2 __attribute__((ext_vector_type(2)));
typedef unsigned u32x4 __attribute__((ext_vector_type(4)));
__device__ __forceinline__ float bf2f(unsigned short u) { return __uint_as_float(((unsigned)u) << 16); }
__device__ __forceinline__ float bflo(unsigned w) { return __uint_as_float(w << 16); }
__device__ __forceinline__ float bfhi(unsigned w) { return __uint_as_float(w & 0xffff0000u); }
__device__ __forceinline__ float sigmoidf_(float x) { return 1.0f / (1.0f + __expf(-x)); }
struct EpiProj {
    static constexpr bool PERM = true, AFTER_DRAIN = false;
    bf16_t* P; float* out;
    __device__ __forceinline__ void operator()(const f32x4 (&acc)[2][2][4][2], const Unit& u, int wr, int wc, int fr, int fq) const {
        const int row0 = u.pm * BM + wr * 64 + fr, col0 = u.pn * BM + wc * 32 + 8 * fq;
        float* fo = nullptr;
        if (u.pn >= 6 && u.pn < 10) {
            const bool isv = u.pn >= 8; const int cb = isv ? 2048 : 1536;
            if (u.pm < 64) fo = out + (isv ? O_VP : O_KP) + (size_t)row0 * 512 + (col0 - cb);
            else           fo = out + (isv ? O_VS : O_KS) + (size_t)(row0 - MP) * 512 + (col0 - cb);
        }
#pragma unroll
        for (int ai = 0; ai < 2; ++ai)
#pragma unroll
            for (int m = 0; m < 4; ++m) {
                const int rr = ai * HALF + m * 16;
                bf16_t* rowp = P + (size_t)(row0 + rr) * NPROJ + col0;
#pragma unroll
                for (int bj = 0; bj < 2; ++bj) {
                    const f32x4 v0 = acc[ai][bj][m][0], v1 = acc[ai][bj][m][1];
                    u32x4 w; w.x = cvt_pk_bf16(v0[0], v0[1]); w.y = cvt_pk_bf16(v0[2], v0[3]); w.z = cvt_pk_bf16(v1[0], v1[1]); w.w = cvt_pk_bf16(v1[2], v1[3]);
                    *(u32x4*)(rowp + bj * HALF) = w;
                    if (fo) { float* f = fo + (size_t)rr * 512 + bj * HALF; *(f32x4*)f = v0; *(f32x4*)(f + 4) = v1; }
                }
            }
    }
};
struct EpiGlu {
    static constexpr bool PERM = true, AFTER_DRAIN = false;
    const bf16_t* P; const float* bglu; float* YSR;
    __device__ __forceinline__ void operator()(const f32x4 (&acc)[2][2][4][2], const Unit& u, int wr, int wc, int fr, int fq) const {
        const int row0 = u.pm * BM + wr * 64 + fr, cv0 = u.pn * HALF + wc * 32 + 8 * fq;
        const f32x4 bv0 = *(const f32x4*)(bglu + cv0), bv1 = *(const f32x4*)(bglu + cv0 + 4), bg0 = *(const f32x4*)(bglu + 512 + cv0), bg1 = *(const f32x4*)(bglu + 512 + cv0 + 4);
#pragma unroll
        for (int ai = 0; ai < 2; ++ai)
#pragma unroll
            for (int m = 0; m < 4; ++m) {
                const int row = row0 + ai * HALF + m * 16;
                const u32x4 zw = *(const u32x4*)(P + (size_t)row * NPROJ + 512 + cv0);
                const float z[8] = {bflo(zw.x), bfhi(zw.x), bflo(zw.y), bfhi(zw.y), bflo(zw.z), bfhi(zw.z), bflo(zw.w), bfhi(zw.w)};
                f32x4 o0, o1;
#pragma unroll
                for (int i = 0; i < 4; ++i) {
                    const float va = acc[ai][0][m][0][i] + bv0[i], ga = acc[ai][1][m][0][i] + bg0[i];
                    const float vb = acc[ai][0][m][1][i] + bv1[i], gb = acc[ai][1][m][1][i] + bg1[i];
                    o0[i] = va * sigmoidf_(ga) * (z[i] * sigmoidf_(z[i]));
                    o1[i] = vb * sigmoidf_(gb) * (z[4 + i] * sigmoidf_(z[4 + i]));
                }
                float* yp = YSR + (size_t)row * 512 + cv0; *(f32x4*)yp = o0; *(f32x4*)(yp + 4) = o1;
            }
    }
};
struct EpiOut {
    static constexpr bool PERM = false, AFTER_DRAIN = false;
    const float* xp; const float* xs; float* out;
    __device__ __forceinline__ void operator()(const f32x4 (&acc)[2][2][4][2], const Unit& u, int wr, int wc, int fr, int fq) const {
        const int row0 = u.pm * BM + wr * 64 + fr, col0 = u.pn * BM + wc * 32 + 4 * fq;
        const float* xb = (u.pm < 64) ? xp + (size_t)row0 * DM : xs + (size_t)(row0 - MP) * DM;
        float* ob = out + O_YP + (size_t)row0 * DM;
#pragma unroll
        for (int ai = 0; ai < 2; ++ai)
#pragma unroll
            for (int m = 0; m < 4; ++m) {
                const size_t ro = (size_t)(ai * HALF + m * 16) * DM + col0;
#pragma unroll
                for (int bj = 0; bj < 2; ++bj)
#pragma unroll
                    for (int n = 0; n < 2; ++n) { const size_t o = ro + bj * HALF + n * 16; *(f32x4*)(ob + o) = *(const f32x4*)(xb + o) + acc[ai][bj][m][n]; }
            }
    }
};
template <class Epi, class Sched, bool ALIGN_EPI = false, bool SP2 = false>
__device__ __forceinline__ void gemm_phase(PG8_LAS unsigned char* lds, const Gemm g, const Sched& S, const Epi& E) {
    const int tid = threadIdx.x, wid = __builtin_amdgcn_readfirstlane(tid >> 6), lane = tid & 63, wr = wid >> 2, wc = wid & 3, fr = lane & 15, fq = lane >> 4;
    const int K = g.K, nt = K / BK;
    unsigned voffA[2], voffB[2];
#pragma unroll
    for (int i = 0; i < 2; ++i) { int R, C; stage_rc(tid * 16 + i * 8192, R, C); const int Rb = Epi::PERM ? ((R & ~31) + perm32(R & 31)) : R;
        voffA[i] = (unsigned)(R * K + C) * 2u; voffB[i] = (unsigned)(Rb * K + C) * 2u; }
    const size_t kstep = (size_t)(BK * 2);
    const size_t hstep = (size_t)HALF * K * 2;
    const size_t tstep = 2 * hstep;
    const unsigned ldsw = (unsigned)wid * 1024u;
    const int aoff = lds_byte(wr * 64 + fr, fq * 8), boff = lds_byte(wc * 32 + fr, fq * 8);
#define PG8_SA(b, h) (((b) * 2 + (h)) * HTB)
#define PG8_SB(b, h) ((4 + (b) * 2 + (h)) * HTB)
#define PG8_STAGE(bufoff, gbase, voff) do { _Pragma("unroll") for (int _i = 0; _i < 2; ++_i) \
        __builtin_amdgcn_global_load_lds((const unsigned*)((const char*)(gbase) + (voff)[_i]), (PG8_LAS unsigned*)(lds + (bufoff) + ldsw + _i * 8192), 16, 0, 0); } while (0)
#define PG8_LDA(dst, b, h) do { _Pragma("unroll") for (int m = 0; m < 4; ++m) _Pragma("unroll") for (int k = 0; k < 2; ++k) dst[m][k] = *(const PG8_LAS bf16x8*)(lds + PG8_SA(b, h) + aoff + m * 2048 + k * 1024); } while (0)
#define PG8_LDB(dst, b, h) do { _Pragma("unroll") for (int n = 0; n < 2; ++n) _Pragma("unroll") for (int k = 0; k < 2; ++k) dst[n][k] = *(const PG8_LAS bf16x8*)(lds + PG8_SB(b, h) + boff + n * 2048 + k * 1024); } while (0)
#define PG8_MMA(ai, bj, At, Bt) do { __builtin_amdgcn_s_setprio(1); _Pragma("unroll") for (int m = 0; m < 4; ++m) _Pragma("unroll") for (int n = 0; n < 2; ++n) _Pragma("unroll") for (int k = 0; k < 2; ++k) \
        acc[ai][bj][m][n] = __builtin_amdgcn_mfma_f32_16x16x32_bf16(Bt[n][k], At[m][k], acc[ai][bj][m][n], 0, 0, 0); __builtin_amdgcn_s_setprio(0); } while (0)
#define PG8_WAIT_V(n) asm volatile("s_waitcnt vmcnt(" #n ")" ::: "memory")
#define PG8_WAIT_L(n) asm volatile("s_waitcnt lgkmcnt(" #n ")" ::: "memory")
#define PG8_BAR __builtin_amdgcn_s_barrier()
#define PG8_SCHED __builtin_amdgcn_sched_barrier(0)
    Unit cur, nxt; int ui = 0;
    if (!S.next(0, cur)) return;
    f32x4 acc[2][2][4][2];
#pragma unroll
    for (int a = 0; a < 2; ++a)
#pragma unroll
        for (int b = 0; b < 2; ++b)
#pragma unroll
            for (int m = 0; m < 4; ++m)
#pragma unroll
                for (int n = 0; n < 2; ++n) acc[a][b][m][n] = (f32x4){0.f, 0.f, 0.f, 0.f};
    bf16x8 At[4][2], B0[2][2], B1[2][2];
    const char* cA = (const char*)g.A + (size_t)cur.pm * tstep; const char* cB = (const char*)g.Bt + (size_t)cur.pn * tstep;
    S.a_ready(cur);
    if constexpr (SP2) {
        PG8_STAGE(PG8_SB(0, 0), cB, voffB); PG8_STAGE(PG8_SB(0, 1), cB + hstep, voffB); PG8_STAGE(PG8_SA(0, 0), cA, voffA); PG8_STAGE(PG8_SA(0, 1), cA + hstep, voffA);
        if (wr == 1) PG8_BAR;
        PG8_WAIT_V(2); PG8_BAR;
        PG8_STAGE(PG8_SB(1, 0), cB + kstep, voffB); PG8_STAGE(PG8_SA(1, 0), cA + kstep, voffA); PG8_STAGE(PG8_SB(1, 1), cB + hstep + kstep, voffB);
        PG8_WAIT_V(6); PG8_BAR;
    } else {
        PG8_STAGE(PG8_SB(0, 0), cB, voffB); PG8_STAGE(PG8_SA(0, 0), cA, voffA); PG8_STAGE(PG8_SB(0, 1), cB + hstep, voffB); PG8_STAGE(PG8_SA(0, 1), cA + hstep, voffA);
        if (wr == 1) PG8_BAR;
        PG8_WAIT_V(4); PG8_BAR;
        PG8_STAGE(PG8_SB(1, 0), cB + kstep, voffB); PG8_STAGE(PG8_SA(1, 0), cA + kstep, voffA); PG8_STAGE(PG8_SB(1, 1), cB + hstep + kstep, voffB);
        PG8_WAIT_V(6); PG8_BAR;
    }
    for (;;) {
        const bool has_next = S.next(ui + 1, nxt);
        const char* nA = has_next ? (const char*)g.A + (size_t)nxt.pm * tstep : cA; const char* nB = has_next ? (const char*)g.Bt + (size_t)nxt.pn * tstep : cB;
        for (int t = 0; t < nt; t += 2) {
            const bool last = (t == nt - 2);
            const char* a1 = cA + (size_t)(t + 1) * kstep;
            const char* a2 = last ? nA : cA + (size_t)(t + 2) * kstep; const char* b2 = last ? nB : cB + (size_t)(t + 2) * kstep;
            const char* a3 = a2 + kstep; const char* b3 = b2 + kstep;
            if (last && has_next) S.a_ready(nxt);
            if constexpr (SP2) {
            PG8_LDB(B0, 0, 0); PG8_LDB(B1, 0, 1); PG8_SCHED; PG8_LDA(At, 0, 0); PG8_STAGE(PG8_SA(1, 1), a1 + hstep, voffA);
            PG8_WAIT_V(8); PG8_WAIT_L(0); PG8_BAR; PG8_MMA(0, 0, At, B0); PG8_MMA(0, 1, At, B1); PG8_BAR; PG8_SCHED;
            PG8_LDA(At, 0, 1); PG8_STAGE(PG8_SB(0, 0), b2, voffB); PG8_STAGE(PG8_SB(0, 1), b2 + hstep, voffB); PG8_STAGE(PG8_SA(0, 0), a2, voffA);
            PG8_WAIT_V(8); PG8_WAIT_L(0); PG8_BAR; PG8_MMA(1, 0, At, B0); PG8_MMA(1, 1, At, B1); PG8_BAR; PG8_SCHED;
            PG8_LDB(B0, 1, 0); PG8_LDB(B1, 1, 1); PG8_SCHED; PG8_LDA(At, 1, 0); PG8_STAGE(PG8_SA(0, 1), a2 + hstep, voffA);
            PG8_WAIT_V(8); PG8_WAIT_L(0); PG8_BAR; PG8_MMA(0, 0, At, B0); PG8_MMA(0, 1, At, B1); PG8_BAR; PG8_SCHED;
            PG8_LDA(At, 1, 1); PG8_STAGE(PG8_SB(1, 0), b3, voffB); PG8_STAGE(PG8_SB(1, 1), b3 + hstep, voffB); PG8_STAGE(PG8_SA(1, 0), a3, voffA);
            PG8_WAIT_V(8); PG8_WAIT_L(0); PG8_BAR; PG8_MMA(1, 0, At, B0); PG8_MMA(1, 1, At, B1); PG8_BAR; PG8_SCHED;
            } else {
            PG8_LDB(B0, 0, 0); PG8_SCHED; PG8_LDA(At, 0, 0); PG8_STAGE(PG8_SA(1, 1), a1 + hstep, voffA);
            PG8_WAIT_L(8); PG8_BAR; PG8_WAIT_L(0); PG8_MMA(0, 0, At, B0); PG8_BAR; PG8_SCHED;
            PG8_LDB(B1, 0, 1); PG8_STAGE(PG8_SB(0, 0), b2, voffB);
            PG8_BAR; PG8_WAIT_L(0); PG8_MMA(0, 1, At, B1); PG8_BAR;
            PG8_LDA(At, 0, 1); PG8_STAGE(PG8_SA(0, 0), a2, voffA);
            PG8_BAR; PG8_WAIT_L(0); PG8_MMA(1, 0, At, B0); PG8_BAR; PG8_SCHED;
            PG8_STAGE(PG8_SB(0, 1), b2 + hstep, voffB);
            PG8_WAIT_V(6); PG8_BAR; PG8_MMA(1, 1, At, B1); PG8_BAR;
            PG8_LDB(B0, 1, 0); PG8_SCHED; PG8_LDA(At, 1, 0); PG8_STAGE(PG8_SA(0, 1), a2 + hstep, voffA);
            PG8_WAIT_L(8); PG8_BAR; PG8_WAIT_L(0); PG8_MMA(0, 0, At, B0); PG8_BAR; PG8_SCHED;
            PG8_LDB(B1, 1, 1); PG8_STAGE(PG8_SB(1, 0), b3, voffB);
            PG8_BAR; PG8_WAIT_L(0); PG8_MMA(0, 1, At, B1); PG8_BAR;
            PG8_LDA(At, 1, 1); PG8_STAGE(PG8_SA(1, 0), a3, voffA);
            PG8_BAR; PG8_WAIT_L(0); PG8_MMA(1, 0, At, B0); PG8_BAR; PG8_SCHED;
            PG8_STAGE(PG8_SB(1, 1), b3 + hstep, voffB);
            PG8_WAIT_V(6); PG8_BAR; PG8_MMA(1, 1, At, B1); PG8_BAR;
            }
        }
        if constexpr (ALIGN_EPI) { if (wr == 0) PG8_BAR; }
        if constexpr (!Epi::AFTER_DRAIN) { E(acc, cur, wr, wc, fr, fq); S.done(cur); }
        if (!has_next) break;
#pragma unroll
        for (int a = 0; a < 2; ++a)
#pragma unroll
            for (int b = 0; b < 2; ++b)
#pragma unroll
                for (int m = 0; m < 4; ++m)
#pragma unroll
                    for (int n = 0; n < 2; ++n) acc[a][b][m][n] = (f32x4){0.f, 0.f, 0.f, 0.f};
        cur = nxt; cA = nA; cB = nB; ++ui;
        if constexpr (ALIGN_EPI) { if (wr == 1) PG8_BAR; }
    }
    PG8_WAIT_V(0);
    if constexpr (!ALIGN_EPI) { if (wr == 0) PG8_BAR; }
    PG8_BAR;
    if constexpr (Epi::AFTER_DRAIN) { E.fused(acc, cur, wr, wc, fr, fq, lds, wid, lane); S.done(cur); }
#undef PG8_SA
#undef PG8_SB
#undef PG8_STAGE
#undef PG8_LDA
#undef PG8_LDB
#undef PG8_MMA
#undef PG8_WAIT_V
#undef PG8_WAIT_L
#undef PG8_BAR
#undef PG8_SCHED
}
}
#define PG8_UNUSED 0
#define GAS __attribute__((address_space(1)))
#define LAS __attribute__((address_space(3)))
typedef unsigned short bf16;
typedef unsigned v4u __attribute__((ext_vector_type(4)));
typedef float f32x4 __attribute__((ext_vector_type(4)));
typedef short bf16x8 __attribute__((ext_vector_type(8)));
typedef GAS unsigned gu32;
typedef GAS unsigned long long gu64;
#define RLX_AGENT __ATOMIC_RELAXED, __HIP_MEMORY_SCOPE_AGENT
#define LDS_WAIT() asm volatile("s_waitcnt lgkmcnt(0)" ::: "memory")
#define VM_WAIT() asm volatile("s_waitcnt vmcnt(0)" ::: "memory")
__device__ __forceinline__ unsigned long long rt() { return __builtin_amdgcn_s_memrealtime(); }
__device__ __forceinline__ unsigned f2bf(float f) { unsigned u = __builtin_bit_cast(unsigned, f); return (u + 0x7fffu + ((u >> 16) & 1u)) >> 16; }
__device__ __forceinline__ unsigned pk2(float lo, float hi) { return f2bf(lo) | (f2bf(hi) << 16); }

#define XB_TMO      128
#define XB_XCNT(j)  (256  + 64 * (j))
#define XB_XSUB(j)  (1280 + 64 * (j))
#define XB_XGEN(j)  (2304 + 64 * (j))
#define XB_TOP      3328
#define XB_TOPGEN   3392
#define XCD_BAR_WORDS 3456
#define XB_SPIN_CAP (1u << 18)

__device__ __forceinline__ unsigned xb_ld(unsigned* p)              { return __hip_atomic_load(p, __ATOMIC_RELAXED, __HIP_MEMORY_SCOPE_AGENT); }
__device__ __forceinline__ unsigned xb_add(unsigned* p, unsigned v) { return __hip_atomic_fetch_add(p, v, __ATOMIC_RELAXED, __HIP_MEMORY_SCOPE_AGENT); }
__device__ __forceinline__ unsigned xb_xcc_id() { return (unsigned)__builtin_amdgcn_s_getreg((3 << 11) | 20) & 0xFu; }
#define XB_SPIN(cond, bar) do { unsigned _sp = 0; while (cond) { __builtin_amdgcn_s_sleep(1); \
    if ((++_sp & 255u) == 0u) { if (xb_ld(&(bar)[XB_TMO])) break; if (_sp > XB_SPIN_CAP) { atomicAdd(&(bar)[XB_TMO], 1u); break; } } } } while (0)

struct XcdBarrier {
    unsigned* bar; unsigned x;
    volatile LAS unsigned* st;
};

__device__ __forceinline__ XcdBarrier xcd_barrier_post(unsigned* bar, volatile LAS unsigned* st) {
    XcdBarrier b; b.bar = bar; b.x = xb_xcc_id(); b.st = st;
    if (threadIdx.x == 0) (void)xb_add(&bar[XB_XCNT(b.x)], 1u);
    return b;
}
__device__ __forceinline__ void xcd_barrier_complete(unsigned* bar, unsigned x, unsigned& nloc, unsigned& nx) {
    const unsigned G = gridDim.x * gridDim.y * gridDim.z;
    unsigned sum, cnt, mine, sp = 0u;
    for (;;) {
        sum = 0u; cnt = 0u; mine = 0u;
#pragma unroll
        for (unsigned j = 0; j < 16; ++j) { const unsigned c = xb_ld(&bar[XB_XCNT(j)]); sum += c; cnt += (c > 0u) ? 1u : 0u; mine = (j == x) ? c : mine; }
        if (sum == G) break;
        __builtin_amdgcn_s_sleep(1);
        if ((++sp & 255u) == 0u) { if (xb_ld(&bar[XB_TMO])) break; if (sp > XB_SPIN_CAP) { atomicAdd(&bar[XB_TMO], 1u); break; } }
    }
    nloc = mine > 0u ? mine : 1u; nx = cnt > 0u ? cnt : 1u;
}

__device__ __forceinline__ void xcd_barrier(const XcdBarrier& b) {
    asm volatile("s_waitcnt vmcnt(0)" ::: "memory");
    __syncthreads();
    if (threadIdx.x == 0) {
        unsigned* bar = b.bar;
        __builtin_amdgcn_s_waitcnt(0);
        unsigned nloc = b.st[0], nx = b.st[1];
        if (nloc == 0u) { xcd_barrier_complete(bar, b.x, nloc, nx); b.st[0] = nloc; b.st[1] = nx; }
        const unsigned old = xb_add(&bar[XB_XSUB(b.x)], 1u);
        const unsigned gen = old / nloc;
        if (old + 1u == (gen + 1u) * nloc) {
            __builtin_amdgcn_fence(__ATOMIC_RELEASE, "agent");
            asm volatile("s_waitcnt vmcnt(0)" ::: "memory");
            const unsigned og = xb_add(&bar[XB_TOP], 1u);
            const unsigned tg = og / nx;
            if (og + 1u == (tg + 1u) * nx) xb_add(&bar[XB_TOPGEN], 1u);
            else XB_SPIN(xb_ld(&bar[XB_TOPGEN]) == tg, bar);
            __builtin_amdgcn_fence(__ATOMIC_ACQUIRE, "agent");
            xb_add(&bar[XB_XGEN(b.x)], 1u);
            asm volatile("s_waitcnt vmcnt(0)" ::: "memory");
        } else {
            XB_SPIN(xb_ld(&bar[XB_XGEN(b.x)]) == gen, bar);
            __builtin_amdgcn_fence(__ATOMIC_ACQUIRE, "agent");
            asm volatile("s_waitcnt vmcnt(0)" ::: "memory");
        }
    }
    __syncthreads();
}
constexpr int NWAVES = 8, NTHR = 512;
constexpr size_t MiB = 1u << 20;
constexpr size_t WS_CTL = 0, CTL_ZERO_BYTES = 1 * MiB;
constexpr size_t WS_WIN = 2 * MiB, WS_WGLU = 8 * MiB, WS_WOUT = 10 * MiB;
constexpr size_t WS_XN = 16 * MiB;
constexpr size_t WS_PROJ = 64 * MiB;
constexpr size_t WS_G = 176 * MiB;
constexpr size_t WS_Y2 = 200 * MiB;
constexpr size_t WS_YAR = 240 * MiB, WS_YSR = 280 * MiB;
constexpr size_t WS_XST = 320 * MiB;
constexpr size_t WS_END = 600 * MiB;
constexpr int CW_BAR = 4096;
constexpr int RING_OFF = 0, RING_BYTES = 131072, LDSCTL_OFF = RING_BYTES, MISC_OFF = LDSCTL_OFF + 320, LDS_BYTES = 147456;
constexpr float RMS_EPS = 1e-6f;
constexpr int NPHASE = 10;

typedef float f32x2 __attribute__((ext_vector_type(2)));
__device__ __forceinline__ float bf2f(unsigned short u) { return __uint_as_float(((unsigned)u) << 16); }
__device__ __forceinline__ float bflo(unsigned w) { return __uint_as_float(w << 16); }
__device__ __forceinline__ float bfhi(unsigned w) { return __uint_as_float(w & 0xffff0000u); }
__device__ __forceinline__ float wave_sum(float v) {
#pragma unroll
    for (int o = 1; o < 64; o <<= 1) v += __shfl_xor(v, o);
    return v;
}
__device__ __forceinline__ void sincos_(float x, float& s, float& c) {
    const float k = rintf(x * 0.63661977236758134f);
    float r = fmaf(-k, 1.5703125f, x); r = fmaf(-k, 4.837512969970703125e-4f, r); r = fmaf(-k, 7.54978995489188216e-8f, r);
    const float z = r * r;
    const float sp = r + r * z * (-1.6666654611e-1f + z * (8.3321608736e-3f + z * (-1.9515295891e-4f)));
    const float cp = 1.0f - 0.5f * z + z * z * (4.166664568298827e-2f + z * (-1.388731625493765e-3f + z * 2.443315711809948e-5f));
    const int q = ((int)k) & 3;
    const float ss = (q & 1) ? cp : sp, cc = (q & 1) ? sp : cp;
    s = (q & 2) ? -ss : ss; c = ((q + 1) & 2) ? -cc : cc;
}
__device__ __forceinline__ float gelu_tanh(float x) {
    const float z = 0.7978845608028654f * (x + 0.044715f * x * x * x);
    const float t = __expf(2.0f * z);
    const float th = 1.0f - 2.0f / (t + 1.0f);
    return 0.5f * x * (1.0f + th);
}
__device__ __forceinline__ float silu_(float z) { return z / (1.0f + __expf(-z)); }

struct Args { const float* in[22]; float* out; unsigned char* ws; int ph_lo, ph_hi; };
enum { I_XP = 0, I_XS, I_CK, I_CV, I_SRE, I_SIM, I_GIN, I_WIN, I_ARE, I_AIM, I_LDT, I_BRE, I_BIM, I_CRE, I_CIM, I_D, I_WGLU, I_BGLU, I_GS, I_GA, I_WOUT, I_GF };

__device__ __forceinline__ void p0_transpose_item(const float* W, int K, int N, bf16* WT, LAS float* scr, int k0, int n0, int drow0, int lane) {
#pragma unroll 8
    for (int i = 0; i < 32; ++i) { const int kk = 2 * i + (lane >> 5); scr[kk * 33 + (lane & 31)] = W[(size_t)(k0 + kk) * N + n0 + (lane & 31)]; }
    LDS_WAIT(); asm volatile("" ::: "memory");
    const int c = lane & 7;
#pragma unroll
    for (int j = 0; j < 4; ++j) { const int n = (lane >> 3) + 8 * j; const LAS float* s = scr + (8 * c) * 33 + n;
        v4u o; o.x = pk2(s[0 * 33], s[1 * 33]); o.y = pk2(s[2 * 33], s[3 * 33]); o.z = pk2(s[4 * 33], s[5 * 33]); o.w = pk2(s[6 * 33], s[7 * 33]);
        *(GAS v4u*)(WT + (size_t)(drow0 + n) * K + k0 + 8 * c) = o; }
    LDS_WAIT(); asm volatile("" ::: "memory");
}
__device__ __forceinline__ int glu_perm(int n) { return n < 512 ? (n >> 7) * 256 + (n & 127) : ((n - 512) >> 7) * 256 + 128 + ((n - 512) & 127); }

__global__ void __launch_bounds__(NTHR, 2) fwd(Args args) {
    extern __shared__ __attribute__((aligned(16))) unsigned char lds[];
    LAS unsigned char* L = (LAS unsigned char*)lds;
    const int tid = threadIdx.x, lane = tid & 63, wave = __builtin_amdgcn_readfirstlane(tid >> 6);
    const int G = gridDim.x, gw = blockIdx.x * NWAVES + wave, NGW = G * NWAVES, gt = blockIdx.x * NTHR + tid, NGT = G * NTHR;
    unsigned char* ws = args.ws; float* out = args.out;
    bf16* Win_t = (bf16*)(ws + WS_WIN); bf16* Wglu_t = (bf16*)(ws + WS_WGLU); bf16* Wout_t = (bf16*)(ws + WS_WOUT);
    bf16* XN = (bf16*)(ws + WS_XN); bf16* PROJ = (bf16*)(ws + WS_PROJ); bf16* GB = (bf16*)(ws + WS_G); bf16* Y2 = (bf16*)(ws + WS_Y2);
    float* YAR = (float*)(ws + WS_YAR); float* YSR = (float*)(ws + WS_YSR); f32x2* XST = (f32x2*)(ws + WS_XST);
    const int lo = args.ph_lo, hi = args.ph_hi;
#define IN(k) (lo <= (k) && (k) < hi)

    if (IN(0)) {
        LAS float* scr = (LAS float*)(L + RING_OFF + wave * 16384);
        constexpr int I_A = 16 * 96, I_B = 8 * 32, I_C = 16 * 32;
        for (int it = gw; it < I_A + I_B + I_C; it += NGW) {
            int r = it;
            if (r < I_A) { const int kb = r / 96, nb = r % 96; p0_transpose_item(args.in[I_WIN], 1024, 3072, Win_t, scr, 64 * kb, 32 * nb, 32 * nb, lane); continue; } r -= I_A;
            if (r < I_B) { const int kb = r / 32, nb = r % 32; p0_transpose_item(args.in[I_WGLU], 512, 1024, Wglu_t, scr, 64 * kb, 32 * nb, glu_perm(32 * nb), lane); continue; } r -= I_B;
            { const int kb = r / 32, nb = r % 32; p0_transpose_item(args.in[I_WOUT], 1024, 1024, Wout_t, scr, 64 * kb, 32 * nb, 32 * nb, lane); }
        }
        const float* gin = args.in[I_GIN];
        for (int m = gw; m < MT; m += NGW) {
            const float* xrow = (m < MP) ? args.in[I_XP] + (size_t)m * DM : args.in[I_XS] + (size_t)(m - MP) * DM;
            const GAS f32x4* xr = (const GAS f32x4*)xrow + lane;
            f32x4 v[4]; float s = 0.f;
#pragma unroll
            for (int j = 0; j < 4; ++j) { v[j] = xr[64 * j]; s += (v[j].x * v[j].x + v[j].y * v[j].y) + (v[j].z * v[j].z + v[j].w * v[j].w); }
            const float rs = 1.0f / sqrtf(wave_sum(s) * (1.f / DM) + RMS_EPS);
            GAS unsigned long long* o8 = (GAS unsigned long long*)(XN + (size_t)m * DM) + lane;
#pragma unroll
            for (int j = 0; j < 4; ++j) { const f32x4 g4 = *((const f32x4*)gin + lane + 64 * j);
                o8[64 * j] = (unsigned long long)pk2(v[j].x * rs * g4.x, v[j].y * rs * g4.y) | ((unsigned long long)pk2(v[j].z * rs * g4.z, v[j].w * rs * g4.w) << 32); }
        }
    }
    if (IN(1)) {
        pg8::Gemm g{XN, Win_t, MT, NPROJ, DM}; pg8::StaticOrder S; S.init(MT, NPROJ, G, (int)blockIdx.x);
        pg8::EpiProj E{PROJ, out};
        pg8::gemm_phase<pg8::EpiProj, pg8::StaticOrder, true, true>(L + RING_OFF, g, S, E);
    }
    if (IN(2)) {
        for (int id = gt; id < 136 * 2048; id += NGT) {
            const int p = id & 63, g = (id >> 6) & 31, seq = id >> 11;
            const float dt = expf(args.in[I_LDT][g]), are = args.in[I_ARE][g * 64 + p], aim = args.in[I_AIM][g * 64 + p];
            const float mag = expf(are * dt); float sn, cs; sincos_(aim * dt, sn, cs);
            const float lr = mag * cs, li = mag * sn, den = are * are + aim * aim;
            const float fre = ((lr - 1.0f) * are + li * aim) / den, fim = (li * are - (lr - 1.0f) * aim) / den;
            float bre[16], bim[16];
#pragma unroll
            for (int c = 0; c < 16; ++c) { const float br = args.in[I_BRE][(g * 64 + p) * 16 + c], bi = args.in[I_BIM][(g * 64 + p) * 16 + c]; bre[c] = fre * br - fim * bi; bim[c] = fre * bi + fim * br; }
            int T, rowbase; float xr, xi;
            if (seq < 8) { T = 2048; rowbase = seq * 2048; xr = 0.f; xi = 0.f; }
            else { T = 4; rowbase = MP + (seq - 8) * 4; xr = args.in[I_SRE][((seq - 8) * 32 + g) * 64 + p]; xi = args.in[I_SIM][((seq - 8) * 32 + g) * 64 + p]; }
            for (int t = 0; t < T; ++t) {
                const v4u* up = (const v4u*)(PROJ + (size_t)(rowbase + t) * NPROJ + g * 16);
                const v4u u0 = up[0], u1 = up[1];
                const float u[16] = {bflo(u0.x), bfhi(u0.x), bflo(u0.y), bfhi(u0.y), bflo(u0.z), bfhi(u0.z), bflo(u0.w), bfhi(u0.w),
                                     bflo(u1.x), bfhi(u1.x), bflo(u1.y), bfhi(u1.y), bflo(u1.z), bfhi(u1.z), bflo(u1.w), bfhi(u1.w)};
                float bur = 0.f, bui = 0.f;
#pragma unroll
                for (int c = 0; c < 16; ++c) { bur = fmaf(bre[c], u[c], bur); bui = fmaf(bim[c], u[c], bui); }
                const float nr = lr * xr - li * xi + bur, ni = lr * xi + li * xr + bui; xr = nr; xi = ni;
                XST[(size_t)(rowbase + t) * 2048 + g * 64 + p] = (f32x2){xr, xi};
            }
            if (seq < 8) { out[O_RP + (seq * 32 + g) * 64 + p] = xr; out[O_IP + (seq * 32 + g) * 64 + p] = xi; }
            else { out[O_RS + ((seq - 8) * 32 + g) * 64 + p] = xr; out[O_IS + ((seq - 8) * 32 + g) * 64 + p] = xi; }
        }
    }
    if (IN(3)) {
        for (int id = gt; id < MT * 512; id += NGT) {
            const int ch = id & 511, m = id >> 9, g = ch >> 4, c = ch & 15;
            const f32x2* xs = XST + (size_t)m * 2048 + g * 64;
            const float* cre = args.in[I_CRE] + (g * 16 + c) * 64; const float* cim = args.in[I_CIM] + (g * 16 + c) * 64;
            float y = 0.f;
            for (int p = 0; p < 64; ++p) { const f32x2 x = xs[p]; y += cre[p] * x.x - cim[p] * x.y; }
            y += args.in[I_D][ch] * bf2f(PROJ[(size_t)m * NPROJ + ch]);
            GB[(size_t)m * 512 + ch] = (bf16)f2bf(gelu_tanh(y));
        }
    }
    if (IN(4)) {
        for (int it = gw; it < MT * 8; it += NGW) {
            const int m = it >> 3, h = it & 7;
            const float qe = bf2f(PROJ[(size_t)m * NPROJ + 1024 + h * 64 + lane]) * 0.125f;
            const bool prompt = m < MP;
            const int b = m >> 11, t = m & 2047, n = (m - MP) >> 2, j = (m - MP) & 3;
            float om[3], ol[3], oo[3];
#pragma unroll
            for (int pi = 0; pi < 3; ++pi) {
                const int d = (pi == 0) ? 1 : (pi == 1) ? 4 : 16;
                float mx = -INFINITY, l = 0.f, acc = 0.f;
                for (int i = 0; i <= 128; ++i) {
                    float kv, vv;
                    if (prompt) { const int tk = t - d * i; if (tk < 0) break;
                        const bf16* rp = PROJ + (size_t)(b * 2048 + tk) * NPROJ + h * 64 + lane; kv = bf2f(rp[1536]); vv = bf2f(rp[2048]); }
                    else { const int pos = 2048 + j - d * i;
                        if (pos >= 2048) { const bf16* rp = PROJ + (size_t)(MP + n * 4 + (pos - 2048)) * NPROJ + h * 64 + lane; kv = bf2f(rp[1536]); vv = bf2f(rp[2048]); }
                        else { const size_t o = (((size_t)n * 2048 + pos) * 8 + h) * 64 + lane; kv = args.in[I_CK][o]; vv = args.in[I_CV][o]; } }
                    const float s = wave_sum(qe * kv);
                    const float mn = fmaxf(mx, s), sc = expf(mx - mn), pe = expf(s - mn);
                    l = l * sc + pe; acc = acc * sc + pe * vv; mx = mn;
                }
                om[pi] = mx; ol[pi] = l; oo[pi] = acc;
            }
            const float bm = fmaxf(om[0], fmaxf(om[1], om[2]));
            const float w0 = expf(om[0] - bm), w1 = expf(om[1] - bm), w2 = expf(om[2] - bm);
            const float num = w0 * oo[0] + w1 * oo[1] + w2 * oo[2], dn = w0 * ol[0] + w1 * ol[1] + w2 * ol[2];
            const float za = bf2f(PROJ[(size_t)m * NPROJ + 2560 + h * 64 + lane]);
            YAR[(size_t)m * 512 + h * 64 + lane] = (num / dn) * silu_(za);
        }
    }
    for (int which = 0; which < 2; ++which) {
        if (!IN(which == 0 ? 5 : 7)) continue;
        const float* src = which == 0 ? YAR : YSR; const float* gg = which == 0 ? args.in[I_GA] : args.in[I_GS]; const int coff = which == 0 ? 512 : 0;
        for (int m = gw; m < MT; m += NGW) {
            const f32x4 a = *((const f32x4*)(src + (size_t)m * 512) + lane), b = *((const f32x4*)(src + (size_t)m * 512) + 64 + lane);
            const float s = (a.x * a.x + a.y * a.y) + (a.z * a.z + a.w * a.w) + (b.x * b.x + b.y * b.y) + (b.z * b.z + b.w * b.w);
            const float rs = 1.0f / sqrtf(wave_sum(s) * (1.f / 512) + RMS_EPS);
            const f32x4 g0 = *((const f32x4*)gg + lane), g1 = *((const f32x4*)gg + 64 + lane);
            unsigned long long* o8 = (unsigned long long*)(Y2 + (size_t)m * DM + coff);
            o8[lane] = (unsigned long long)pk2(a.x * rs * g0.x, a.y * rs * g0.y) | ((unsigned long long)pk2(a.z * rs * g0.z, a.w * rs * g0.w) << 32);
            o8[64 + lane] = (unsigned long long)pk2(b.x * rs * g1.x, b.y * rs * g1.y) | ((unsigned long long)pk2(b.z * rs * g1.z, b.w * rs * g1.w) << 32);
        }
    }
    if (IN(6)) {
        pg8::Gemm g{GB, Wglu_t, MT, 1024, 512}; pg8::StaticOrder S; S.init(MT, 1024, G, (int)blockIdx.x);
        pg8::EpiGlu E{PROJ, args.in[I_BGLU], YSR};
        pg8::gemm_phase<pg8::EpiGlu, pg8::StaticOrder, true, true>(L + RING_OFF, g, S, E);
    }
    if (IN(8)) {
        pg8::Gemm g{Y2, Wout_t, MT, DM, DM}; pg8::StaticOrder S; S.init(MT, DM, G, (int)blockIdx.x);
        pg8::EpiOut E{args.in[I_XP], args.in[I_XS], out};
        pg8::gemm_phase<pg8::EpiOut, pg8::StaticOrder, true, true>(L + RING_OFF, g, S, E);
    }
    if (IN(9)) {
        const float* gf = args.in[I_GF];
        for (int m = gw; m < MT; m += NGW) {
            GAS f32x4* yr = (GAS f32x4*)(out + O_YP + (size_t)m * DM) + lane;
            f32x4 v[4]; float s = 0.f;
#pragma unroll
            for (int j = 0; j < 4; ++j) { v[j] = yr[64 * j]; s += (v[j].x * v[j].x + v[j].y * v[j].y) + (v[j].z * v[j].z + v[j].w * v[j].w); }
            const float rs = 1.0f / sqrtf(wave_sum(s) * (1.f / DM) + RMS_EPS);
#pragma unroll
            for (int j = 0; j < 4; ++j) { const f32x4 g4 = *((const f32x4*)gf + lane + 64 * j); yr[64 * j] = v[j] * rs * g4; }
        }
    }
#undef IN
}

extern "C" void kernel_launch(void* const* d_in, const int* in_sizes, int n_in, void* d_out, int out_size, void* d_ws, size_t ws_size, hipStream_t stream) {
    static int grid = 0;
    if (grid == 0) {
        if (n_in != 22 || out_size != (int)O_END || ws_size < WS_END) { fprintf(stderr, "kernel_launch: unexpected shapes n_in %d out %d ws %zu\n", n_in, out_size, ws_size); grid = -1; return; }
        int dev = 0, cus = 0, per_cu = 0;
        if (hipGetDevice(&dev) != hipSuccess || hipDeviceGetAttribute(&cus, hipDeviceAttributeMultiprocessorCount, dev) != hipSuccess) { grid = -1; return; }
        if (hipFuncSetAttribute((const void*)fwd, hipFuncAttributeMaxDynamicSharedMemorySize, LDS_BYTES) != hipSuccess) { fprintf(stderr, "kernel_launch: hipFuncSetAttribute failed\n"); grid = -1; return; }
        if (hipOccupancyMaxActiveBlocksPerMultiprocessor(&per_cu, (const void*)fwd, NTHR, LDS_BYTES) != hipSuccess || per_cu < 1) fprintf(stderr, "kernel_launch: occupancy query says %d\n", per_cu);
        (void)hipGetLastError();
        grid = cus;
    }
    if (grid < 0) return;
    (void)hipMemsetAsync((char*)d_ws + WS_CTL, 0, CTL_ZERO_BYTES, stream);
    Args a{};
    for (int i = 0; i < 22; ++i) a.in[i] = (const float*)d_in[i];
    a.out = (float*)d_out; a.ws = (unsigned char*)d_ws;
    for (int ph = 0; ph < NPHASE; ++ph) {
        a.ph_lo = ph; a.ph_hi = ph + 1;
        hipLaunchKernelGGL(fwd, dim3(grid), dim3(NTHR), LDS_BYTES, stream, a);
    }
}
```

```cpp
#include <hip/hip_runtime.h>
#include <cstdio>
#include <cstdint>
constexpr size_t O_YP = 0, O_YS = 16777216, O_KP = 17301504, O_VP = 25690112, O_RP = 34078720, O_IP = 34095104,
                 O_KS = 34111488, O_VS = 34373632, O_RS = 34635776, O_IS = 34897920, O_END = 35160064;
constexpr int MP = 16384, MS = 512, MT = MP + MS;
constexpr int DM = 1024, NPROJ = 3072;
namespace pg8 {
#define PG8_LAS __attribute__((address_space(3)))
typedef unsigned short bf16_t;
typedef short bf16x8 __attribute__((ext_vector_type(8)));
typedef float f32x4 __attribute__((ext_vector_type(4)));
typedef unsigned u32x4 __attribute__((ext_vector_type(4)));
constexpr int BM = 256, BK = 64, HALF = 128, HTB = HALF * BK * 2  , STAGE_BYTES = 8 * HTB, NXCD = 8, WGM = 8;

__host__ __device__ __forceinline__ int lds_byte(int r, int c) { const int st = (r >> 4) * 2 + (c >> 5), rr = r & 15, cc = c & 31, ob = rr * 64 + cc * 2; return st * 1024 + (ob ^ (((ob >> 9) & 1) << 5)); }
__host__ __device__ __forceinline__ void stage_rc(int b, int& R, int& C) { const int st = b / 1024, sb = b % 1024, swz = sb ^ (((sb >> 9) & 1) << 5); R = (st >> 1) * 16 + swz / 64; C = (st & 1) * 32 + (swz % 64) / 2; }
__host__ __device__ __forceinline__ int perm32(int rho) { const int n = rho >> 4, i = rho & 15; return 8 * (i >> 2) + 4 * n + (i & 3); }

struct Unit { int pm, pn; };
struct Gemm { const bf16_t* A; const bf16_t* Bt; int M, N, K; };

struct StaticOrder {
    int nM, nN, nwg, G, c;
    __host__ __device__ void init(int M, int N, int G_, int c_) { nM = M / BM; nN = N / BM; nwg = nM * nN; G = G_; c = c_; }
    __host__ __device__ bool next(int i, Unit& u) const {
        const long L = (long)i * G + c; if (L >= nwg) return false;
        int wgid = (int)L; { const int q = nwg / NXCD, r = nwg % NXCD, xcd = wgid % NXCD, off = wgid / NXCD; wgid = (xcd < r ? xcd * (q + 1) : r * (q + 1) + (xcd - r) * q) + off; }
        const int nig = WGM * nN, gid = wgid / nig, fm = gid * WGM, gsz = (nM - fm) < WGM ? (nM - fm) : WGM;
        u.pm = fm + ((wgid % nig) % gsz); u.pn = (wgid % nig) / gsz; return true;
    }
    __device__ __forceinline__ void a_ready(const Unit&) const {}
    __device__ __forceinline__ void done(const Unit&) const {}
};

__device__ __forceinline__ unsigned cvt_pk_bf16(float lo, float hi) { unsigned r; asm volatile("v_cvt_pk_bf16_f32 %0, %1, %2" : "=v"(r) : "v"(lo), "v"(hi)); return r; }
typedef float f32x2 __attribute__((ext_vector_type(2)));
typedef unsigned u32x4 __attribute__((ext_vector_type(4)));
__device__ __forceinline__ float bf2f(unsigned short u) { return __uint_as_float(((unsigned)u) << 16); }
__device__ __forceinline__ float bflo(unsigned w) { return __uint_as_float(w << 16); }
__device__ __forceinline__ float bfhi(unsigned w) { return __uint_as_float(w & 0xffff0000u); }
__device__ __forceinline__ float sigmoidf_(float x) { return 1.0f / (1.0f + __expf(-x)); }
struct EpiProj {
    static constexpr bool PERM = true, AFTER_DRAIN = false;
    bf16_t* P; float* out;
    __device__ __forceinline__ void operator()(const f32x4 (&acc)[2][2][4][2], const Unit& u, int wr, int wc, int fr, int fq) const {
        const int row0 = u.pm * BM + wr * 64 + fr, col0 = u.pn * BM + wc * 32 + 8 * fq;
        float* fo = nullptr;
        if (u.pn >= 6 && u.pn < 10) {
            const bool isv = u.pn >= 8; const int cb = isv ? 2048 : 1536;
            if (u.pm < 64) fo = out + (isv ? O_VP : O_KP) + (size_t)row0 * 512 + (col0 - cb);
            else           fo = out + (isv ? O_VS : O_KS) + (size_t)(row0 - MP) * 512 + (col0 - cb);
        }
#pragma unroll
        for (int ai = 0; ai < 2; ++ai)
#pragma unroll
            for (int m = 0; m < 4; ++m) {
                const int rr = ai * HALF + m * 16;
                bf16_t* rowp = P + (size_t)(row0 + rr) * NPROJ + col0;
#pragma unroll
                for (int bj = 0; bj < 2; ++bj) {
                    const f32x4 v0 = acc[ai][bj][m][0], v1 = acc[ai][bj][m][1];
                    u32x4 w; w.x = cvt_pk_bf16(v0[0], v0[1]); w.y = cvt_pk_bf16(v0[2], v0[3]); w.z = cvt_pk_bf16(v1[0], v1[1]); w.w = cvt_pk_bf16(v1[2], v1[3]);
                    *(u32x4*)(rowp + bj * HALF) = w;
                    if (fo) { float* f = fo + (size_t)rr * 512 + bj * HALF; *(f32x4*)f = v0; *(f32x4*)(f + 4) = v1; }
                }
            }
    }
};
struct EpiGlu {
    static constexpr bool PERM = true, AFTER_DRAIN = false;
    const bf16_t* P; const float* bglu; float* YSR;
    __device__ __forceinline__ void operator()(const f32x4 (&acc)[2][2][4][2], const Unit& u, int wr, int wc, int fr, int fq) const {
        const int row0 = u.pm * BM + wr * 64 + fr, cv0 = u.pn * HALF + wc * 32 + 8 * fq;
        const f32x4 bv0 = *(const f32x4*)(bglu + cv0), bv1 = *(const f32x4*)(bglu + cv0 + 4), bg0 = *(const f32x4*)(bglu + 512 + cv0), bg1 = *(const f32x4*)(bglu + 512 + cv0 + 4);
#pragma unroll
        for (int ai = 0; ai < 2; ++ai)
#pragma unroll
            for (int m = 0; m < 4; ++m) {
                const int row = row0 + ai * HALF + m * 16;
                const u32x4 zw = *(const u32x4*)(P + (size_t)row * NPROJ + 512 + cv0);
                const float z[8] = {bflo(zw.x), bfhi(zw.x), bflo(zw.y), bfhi(zw.y), bflo(zw.z), bfhi(zw.z), bflo(zw.w), bfhi(zw.w)};
                f32x4 o0, o1;
#pragma unroll
                for (int i = 0; i < 4; ++i) {
                    const float va = acc[ai][0][m][0][i] + bv0[i], ga = acc[ai][1][m][0][i] + bg0[i];
                    const float vb = acc[ai][0][m][1][i] + bv1[i], gb = acc[ai][1][m][1][i] + bg1[i];
                    o0[i] = va * sigmoidf_(ga) * (z[i] * sigmoidf_(z[i]));
                    o1[i] = vb * sigmoidf_(gb) * (z[4 + i] * sigmoidf_(z[4 + i]));
                }
                float* yp = YSR + (size_t)row * 512 + cv0; *(f32x4*)yp = o0; *(f32x4*)(yp + 4) = o1;
            }
    }
};
struct EpiOut {
    static constexpr bool PERM = false, AFTER_DRAIN = false;
    const float* xp; const float* xs; float* out;
    __device__ __forceinline__ void operator()(const f32x4 (&acc)[2][2][4][2], const Unit& u, int wr, int wc, int fr, int fq) const {
        const int row0 = u.pm * BM + wr * 64 + fr, col0 = u.pn * BM + wc * 32 + 4 * fq;
        const float* xb = (u.pm < 64) ? xp + (size_t)row0 * DM : xs + (size_t)(row0 - MP) * DM;
        float* ob = out + O_YP + (size_t)row0 * DM;
#pragma unroll
        for (int ai = 0; ai < 2; ++ai)
#pragma unroll
            for (int m = 0; m < 4; ++m) {
                const size_t ro = (size_t)(ai * HALF + m * 16) * DM + col0;
#pragma unroll
                for (int bj = 0; bj < 2; ++bj)
#pragma unroll
                    for (int n = 0; n < 2; ++n) { const size_t o = ro + bj * HALF + n * 16; *(f32x4*)(ob + o) = *(const f32x4*)(xb + o) + acc[ai][bj][m][n]; }
            }
    }
};
template <class Epi, class Sched, bool ALIGN_EPI = false, bool SP2 = false>
__device__ __forceinline__ void gemm_phase(PG8_LAS unsigned char* lds, const Gemm g, const Sched& S, const Epi& E) {
    const int tid = threadIdx.x, wid = __builtin_amdgcn_readfirstlane(tid >> 6), lane = tid & 63, wr = wid >> 2, wc = wid & 3, fr = lane & 15, fq = lane >> 4;
    const int K = g.K, nt = K / BK;
    unsigned voffA[2], voffB[2];
#pragma unroll
    for (int i = 0; i < 2; ++i) { int R, C; stage_rc(tid * 16 + i * 8192, R, C); const int Rb = Epi::PERM ? ((R & ~31) + perm32(R & 31)) : R;
        voffA[i] = (unsigned)(R * K + C) * 2u; voffB[i] = (unsigned)(Rb * K + C) * 2u; }
    const size_t kstep = (size_t)(BK * 2);
    const size_t hstep = (size_t)HALF * K * 2;
    const size_t tstep = 2 * hstep;
    const unsigned ldsw = (unsigned)wid * 1024u;
    const int aoff = lds_byte(wr * 64 + fr, fq * 8), boff = lds_byte(wc * 32 + fr, fq * 8);
#define PG8_SA(b, h) (((b) * 2 + (h)) * HTB)
#define PG8_SB(b, h) ((4 + (b) * 2 + (h)) * HTB)
#define PG8_STAGE(bufoff, gbase, voff) do { _Pragma("unroll") for (int _i = 0; _i < 2; ++_i) \
        __builtin_amdgcn_global_load_lds((const unsigned*)((const char*)(gbase) + (voff)[_i]), (PG8_LAS unsigned*)(lds + (bufoff) + ldsw + _i * 8192), 16, 0, 0); } while (0)
#define PG8_LDA(dst, b, h) do { _Pragma("unroll") for (int m = 0; m < 4; ++m) _Pragma("unroll") for (int k = 0; k < 2; ++k) dst[m][k] = *(const PG8_LAS bf16x8*)(lds + PG8_SA(b, h) + aoff + m * 2048 + k * 1024); } while (0)
#define PG8_LDB(dst, b, h) do { _Pragma("unroll") for (int n = 0; n < 2; ++n) _Pragma("unroll") for (int k = 0; k < 2; ++k) dst[n][k] = *(const PG8_LAS bf16x8*)(lds + PG8_SB(b, h) + boff + n * 2048 + k * 1024); } while (0)
#define PG8_MMA(ai, bj, At, Bt) do { __builtin_amdgcn_s_setprio(1); _Pragma("unroll") for (int m = 0; m < 4; ++m) _Pragma("unroll") for (int n = 0; n < 2; ++n) _Pragma("unroll") for (int k = 0; k < 2; ++k) \
        acc[ai][bj][m][n] = __builtin_amdgcn_mfma_f32_16x16x32_bf16(Bt[n][k], At[m][k], acc[ai][bj][m][n], 0, 0, 0); __builtin_amdgcn_s_setprio(0); } while (0)
#define PG8_WAIT_V(n) asm volatile("s_waitcnt vmcnt(" #n ")" ::: "memory")
#define PG8_WAIT_L(n) asm volatile("s_waitcnt lgkmcnt(" #n ")" ::: "memory")
#define PG8_BAR __builtin_amdgcn_s_barrier()
#define PG8_SCHED __builtin_amdgcn_sched_barrier(0)
    Unit cur, nxt; int ui = 0;
    if (!S.next(0, cur)) return;
    f32x4 acc[2][2][4][2];
#pragma unroll
    for (int a = 0; a < 2; ++a)
#pragma unroll
        for (int b = 0; b < 2; ++b)
#pragma unroll
            for (int m = 0; m < 4; ++m)
#pragma unroll
                for (int n = 0; n < 2; ++n) acc[a][b][m][n] = (f32x4){0.f, 0.f, 0.f, 0.f};
    bf16x8 At[4][2], B0[2][2], B1[2][2];
    const char* cA = (const char*)g.A + (size_t)cur.pm * tstep; const char* cB = (const char*)g.Bt + (size_t)cur.pn * tstep;
    S.a_ready(cur);
    if constexpr (SP2) {
        PG8_STAGE(PG8_SB(0, 0), cB, voffB); PG8_STAGE(PG8_SB(0, 1), cB + hstep, voffB); PG8_STAGE(PG8_SA(0, 0), cA, voffA); PG8_STAGE(PG8_SA(0, 1), cA + hstep, voffA);
        if (wr == 1) PG8_BAR;
        PG8_WAIT_V(2); PG8_BAR;
        PG8_STAGE(PG8_SB(1, 0), cB + kstep, voffB); PG8_STAGE(PG8_SA(1, 0), cA + kstep, voffA); PG8_STAGE(PG8_SB(1, 1), cB + hstep + kstep, voffB);
        PG8_WAIT_V(6); PG8_BAR;
    } else {
        PG8_STAGE(PG8_SB(0, 0), cB, voffB); PG8_STAGE(PG8_SA(0, 0), cA, voffA); PG8_STAGE(PG8_SB(0, 1), cB + hstep, voffB); PG8_STAGE(PG8_SA(0, 1), cA + hstep, voffA);
        if (wr == 1) PG8_BAR;
        PG8_WAIT_V(4); PG8_BAR;
        PG8_STAGE(PG8_SB(1, 0), cB + kstep, voffB); PG8_STAGE(PG8_SA(1, 0), cA + kstep, voffA); PG8_STAGE(PG8_SB(1, 1), cB + hstep + kstep, voffB);
        PG8_WAIT_V(6); PG8_BAR;
    }
    for (;;) {
        const bool has_next = S.next(ui + 1, nxt);
        const char* nA = has_next ? (const char*)g.A + (size_t)nxt.pm * tstep : cA; const char* nB = has_next ? (const char*)g.Bt + (size_t)nxt.pn * tstep : cB;
        for (int t = 0; t < nt; t += 2) {
            const bool last = (t == nt - 2);
            const char* a1 = cA + (size_t)(t + 1) * kstep;
            const char* a2 = last ? nA : cA + (size_t)(t + 2) * kstep; const char* b2 = last ? nB : cB + (size_t)(t + 2) * kstep;
            const char* a3 = a2 + kstep; const char* b3 = b2 + kstep;
            if (last && has_next) S.a_ready(nxt);
            if constexpr (SP2) {
            PG8_LDB(B0, 0, 0); PG8_LDB(B1, 0, 1); PG8_SCHED; PG8_LDA(At, 0, 0); PG8_STAGE(PG8_SA(1, 1), a1 + hstep, voffA);
            PG8_WAIT_V(8); PG8_WAIT_L(0); PG8_BAR; PG8_MMA(0, 0, At, B0); PG8_MMA(0, 1, At, B1); PG8_BAR; PG8_SCHED;
            PG8_LDA(At, 0, 1); PG8_STAGE(PG8_SB(0, 0), b2, voffB); PG8_STAGE(PG8_SB(0, 1), b2 + hstep, voffB); PG8_STAGE(PG8_SA(0, 0), a2, voffA);
            PG8_WAIT_V(8); PG8_WAIT_L(0); PG8_BAR; PG8_MMA(1, 0, At, B0); PG8_MMA(1, 1, At, B1); PG8_BAR; PG8_SCHED;
            PG8_LDB(B0, 1, 0); PG8_LDB(B1, 1, 1); PG8_SCHED; PG8_LDA(At, 1, 0); PG8_STAGE(PG8_SA(0, 1), a2 + hstep, voffA);
            PG8_WAIT_V(8); PG8_WAIT_L(0); PG8_BAR; PG8_MMA(0, 0, At, B0); PG8_MMA(0, 1, At, B1); PG8_BAR; PG8_SCHED;
            PG8_LDA(At, 1, 1); PG8_STAGE(PG8_SB(1, 0), b3, voffB); PG8_STAGE(PG8_SB(1, 1), b3 + hstep, voffB); PG8_STAGE(PG8_SA(1, 0), a3, voffA);
            PG8_WAIT_V(8); PG8_WAIT_L(0); PG8_BAR; PG8_MMA(1, 0, At, B0); PG8_MMA(1, 1, At, B1); PG8_BAR; PG8_SCHED;
            } else {
            PG8_LDB(B0, 0, 0); PG8_SCHED; PG8_LDA(At, 0, 0); PG8_STAGE(PG8_SA(1, 1), a1 + hstep, voffA);
            PG8_WAIT_L(8); PG8_BAR; PG8_WAIT_L(0); PG8_MMA(0, 0, At, B0); PG8_BAR; PG8_SCHED;
            PG8_LDB(B1, 0, 1); PG8_STAGE(PG8_SB(0, 0), b2, voffB);
            PG8_BAR; PG8_WAIT_L(0); PG8_MMA(0, 1, At, B1); PG8_BAR;
            PG8_LDA(At, 0, 1); PG8_STAGE(PG8_SA(0, 0), a2, voffA);
            PG8_BAR; PG8_WAIT_L(0); PG8_MMA(1, 0, At, B0); PG8_BAR; PG8_SCHED;
            PG8_STAGE(PG8_SB(0, 1), b2 + hstep, voffB);
            PG8_WAIT_V(6); PG8_BAR; PG8_MMA(1, 1, At, B1); PG8_BAR;
            PG8_LDB(B0, 1, 0); PG8_SCHED; PG8_LDA(At, 1, 0); PG8_STAGE(PG8_SA(0, 1), a2 + hstep, voffA);
            PG8_WAIT_L(8); PG8_BAR; PG8_WAIT_L(0); PG8_MMA(0, 0, At, B0); PG8_BAR; PG8_SCHED;
            PG8_LDB(B1, 1, 1); PG8_STAGE(PG8_SB(1, 0), b3, voffB);
            PG8_BAR; PG8_WAIT_L(0); PG8_MMA(0, 1, At, B1); PG8_BAR;
            PG8_LDA(At, 1, 1); PG8_STAGE(PG8_SA(1, 0), a3, voffA);
            PG8_BAR; PG8_WAIT_L(0); PG8_MMA(1, 0, At, B0); PG8_BAR; PG8_SCHED;
            PG8_STAGE(PG8_SB(1, 1), b3 + hstep, voffB);
            PG8_WAIT_V(6); PG8_BAR; PG8_MMA(1, 1, At, B1); PG8_BAR;
            }
        }
        if constexpr (ALIGN_EPI) { if (wr == 0) PG8_BAR; }
        if constexpr (!Epi::AFTER_DRAIN) { E(acc, cur, wr, wc, fr, fq); S.done(cur); }
        if (!has_next) break;
#pragma unroll
        for (int a = 0; a < 2; ++a)
#pragma unroll
            for (int b = 0; b < 2; ++b)
#pragma unroll
                for (int m = 0; m < 4; ++m)
#pragma unroll
                    for (int n = 0; n < 2; ++n) acc[a][b][m][n] = (f32x4){0.f, 0.f, 0.f, 0.f};
        cur = nxt; cA = nA; cB = nB; ++ui;
        if constexpr (ALIGN_EPI) { if (wr == 1) PG8_BAR; }
    }
    PG8_WAIT_V(0);
    if constexpr (!ALIGN_EPI) { if (wr == 0) PG8_BAR; }
    PG8_BAR;
    if constexpr (Epi::AFTER_DRAIN) { E.fused(acc, cur, wr, wc, fr, fq, lds, wid, lane); S.done(cur); }
#undef PG8_SA
#undef PG8_SB
#undef PG8_STAGE
#undef PG8_LDA
#undef PG8_LDB
#undef PG8_MMA
#undef PG8_WAIT_V
#undef PG8_WAIT_L
#undef PG8_BAR
#undef PG8_SCHED
}
}
#define PG8_UNUSED 0
#define GAS __attribute__((address_space(1)))
#define LAS __attribute__((address_space(3)))
typedef unsigned short bf16;
typedef unsigned v4u __attribute__((ext_vector_type(4)));
typedef float f32x4 __attribute__((ext_vector_type(4)));
typedef short bf16x8 __attribute__((ext_vector_type(8)));
typedef GAS unsigned gu32;
typedef GAS unsigned long long gu64;
#define RLX_AGENT __ATOMIC_RELAXED, __HIP_MEMORY_SCOPE_AGENT
#define LDS_WAIT() asm volatile("s_waitcnt lgkmcnt(0)" ::: "memory")
#define VM_WAIT() asm volatile("s_waitcnt vmcnt(0)" ::: "memory")
__device__ __forceinline__ unsigned long long rt() { return __builtin_amdgcn_s_memrealtime(); }
__device__ __forceinline__ unsigned f2bf(float f) { unsigned u = __builtin_bit_cast(unsigned, f); return (u + 0x7fffu + ((u >> 16) & 1u)) >> 16; }
__device__ __forceinline__ unsigned pk2(float lo, float hi) { return f2bf(lo) | (f2bf(hi) << 16); }

#define XB_TMO      128
#define XB_XCNT(j)  (256  + 64 * (j))
#define XB_XSUB(j)  (1280 + 64 * (j))
#define XB_XGEN(j)  (2304 + 64 * (j))
#define XB_TOP      3328
#define XB_TOPGEN   3392
#define XCD_BAR_WORDS 3456
#define XB_SPIN_CAP (1u << 18)

__device__ __forceinline__ unsigned xb_ld(unsigned* p)              { return __hip_atomic_load(p, __ATOMIC_RELAXED, __HIP_MEMORY_SCOPE_AGENT); }
__device__ __forceinline__ unsigned xb_add(unsigned* p, unsigned v) { return __hip_atomic_fetch_add(p, v, __ATOMIC_RELAXED, __HIP_MEMORY_SCOPE_AGENT); }
__device__ __forceinline__ unsigned xb_xcc_id() { return (unsigned)__builtin_amdgcn_s_getreg((3 << 11) | 20) & 0xFu; }
#define XB_SPIN(cond, bar) do { unsigned _sp = 0; while (cond) { __builtin_amdgcn_s_sleep(1); \
    if ((++_sp & 255u) == 0u) { if (xb_ld(&(bar)[XB_TMO])) break; if (_sp > XB_SPIN_CAP) { atomicAdd(&(bar)[XB_TMO], 1u); break; } } } } while (0)

struct XcdBarrier {
    unsigned* bar; unsigned x;
    volatile LAS unsigned* st;
};

__device__ __forceinline__ XcdBarrier xcd_barrier_post(unsigned* bar, volatile LAS unsigned* st) {
    XcdBarrier b; b.bar = bar; b.x = xb_xcc_id(); b.st = st;
    if (threadIdx.x == 0) (void)xb_add(&bar[XB_XCNT(b.x)], 1u);
    return b;
}
__device__ __forceinline__ void xcd_barrier_complete(unsigned* bar, unsigned x, unsigned& nloc, unsigned& nx) {
    const unsigned G = gridDim.x * gridDim.y * gridDim.z;
    unsigned sum, cnt, mine, sp = 0u;
    for (;;) {
        sum = 0u; cnt = 0u; mine = 0u;
#pragma unroll
        for (unsigned j = 0; j < 16; ++j) { const unsigned c = xb_ld(&bar[XB_XCNT(j)]); sum += c; cnt += (c > 0u) ? 1u : 0u; mine = (j == x) ? c : mine; }
        if (sum == G) break;
        __builtin_amdgcn_s_sleep(1);
        if ((++sp & 255u) == 0u) { if (xb_ld(&bar[XB_TMO])) break; if (sp > XB_SPIN_CAP) { atomicAdd(&bar[XB_TMO], 1u); break; } }
    }
    nloc = mine > 0u ? mine : 1u; nx = cnt > 0u ? cnt : 1u;
}

__device__ __forceinline__ void xcd_barrier(const XcdBarrier& b) {
    asm volatile("s_waitcnt vmcnt(0)" ::: "memory");
    __syncthreads();
    if (threadIdx.x == 0) {
        unsigned* bar = b.bar;
        __builtin_amdgcn_s_waitcnt(0);
        unsigned nloc = b.st[0], nx = b.st[1];
        if (nloc == 0u) { xcd_barrier_complete(bar, b.x, nloc, nx); b.st[0] = nloc; b.st[1] = nx; }
        const unsigned old = xb_add(&bar[XB_XSUB(b.x)], 1u);
        const unsigned gen = old / nloc;
        if (old + 1u == (gen + 1u) * nloc) {
            __builtin_amdgcn_fence(__ATOMIC_RELEASE, "agent");
            asm volatile("s_waitcnt vmcnt(0)" ::: "memory");
            const unsigned og = xb_add(&bar[XB_TOP], 1u);
            const unsigned tg = og / nx;
            if (og + 1u == (tg + 1u) * nx) xb_add(&bar[XB_TOPGEN], 1u);
            else XB_SPIN(xb_ld(&bar[XB_TOPGEN]) == tg, bar);
            __builtin_amdgcn_fence(__ATOMIC_ACQUIRE, "agent");
            xb_add(&bar[XB_XGEN(b.x)], 1u);
            asm volatile("s_waitcnt vmcnt(0)" ::: "memory");
        } else {
            XB_SPIN(xb_ld(&bar[XB_XGEN(b.x)]) == gen, bar);
            __builtin_amdgcn_fence(__ATOMIC_ACQUIRE, "agent");
            asm volatile("s_waitcnt vmcnt(0)" ::: "memory");
        }
    }
    __syncthreads();
}
constexpr int NWAVES = 8, NTHR = 512;
constexpr size_t MiB = 1u << 20;
constexpr size_t WS_CTL = 0, CTL_ZERO_BYTES = 1 * MiB;
constexpr size_t WS_WIN = 2 * MiB, WS_WGLU = 8 * MiB, WS_WOUT = 10 * MiB;
constexpr size_t WS_XN = 16 * MiB;
constexpr size_t WS_PROJ = 64 * MiB;
constexpr size_t WS_G = 176 * MiB;
constexpr size_t WS_Y2 = 200 * MiB;
constexpr size_t WS_YAR = 240 * MiB, WS_YSR = 280 * MiB;
constexpr size_t WS_XST = 320 * MiB;
constexpr size_t WS_END = 600 * MiB;
constexpr int CW_BAR = 4096;
constexpr int RING_OFF = 0, RING_BYTES = 131072, LDSCTL_OFF = RING_BYTES, MISC_OFF = LDSCTL_OFF + 320, LDS_BYTES = 147456;
constexpr float RMS_EPS = 1e-6f;
constexpr int NPHASE = 10;

typedef float f32x2 __attribute__((ext_vector_type(2)));
__device__ __forceinline__ float bf2f(unsigned short u) { return __uint_as_float(((unsigned)u) << 16); }
__device__ __forceinline__ float bflo(unsigned w) { return __uint_as_float(w << 16); }
__device__ __forceinline__ float bfhi(unsigned w) { return __uint_as_float(w & 0xffff0000u); }
__device__ __forceinline__ float wave_sum(float v) {
#pragma unroll
    for (int o = 1; o < 64; o <<= 1) v += __shfl_xor(v, o);
    return v;
}
__device__ __forceinline__ void sincos_(float x, float& s, float& c) {
    const float k = rintf(x * 0.63661977236758134f);
    float r = fmaf(-k, 1.5703125f, x); r = fmaf(-k, 4.837512969970703125e-4f, r); r = fmaf(-k, 7.54978995489188216e-8f, r);
    const float z = r * r;
    const float sp = r + r * z * (-1.6666654611e-1f + z * (8.3321608736e-3f + z * (-1.9515295891e-4f)));
    const float cp = 1.0f - 0.5f * z + z * z * (4.166664568298827e-2f + z * (-1.388731625493765e-3f + z * 2.443315711809948e-5f));
    const int q = ((int)k) & 3;
    const float ss = (q & 1) ? cp : sp, cc = (q & 1) ? sp : cp;
    s = (q & 2) ? -ss : ss; c = ((q + 1) & 2) ? -cc : cc;
}
__device__ __forceinline__ float gelu_tanh(float x) {
    const float z = 0.7978845608028654f * (x + 0.044715f * x * x * x);
    const float t = __expf(2.0f * z);
    const float th = 1.0f - 2.0f / (t + 1.0f);
    return 0.5f * x * (1.0f + th);
}
__device__ __forceinline__ float silu_(float z) { return z / (1.0f + __expf(-z)); }

struct Args { const float* in[22]; float* out; unsigned char* ws; int ph_lo, ph_hi; };
enum { I_XP = 0, I_XS, I_CK, I_CV, I_SRE, I_SIM, I_GIN, I_WIN, I_ARE, I_AIM, I_LDT, I_BRE, I_BIM, I_CRE, I_CIM, I_D, I_WGLU, I_BGLU, I_GS, I_GA, I_WOUT, I_GF };

__device__ __forceinline__ void p0_transpose_item(const float* W, int K, int N, bf16* WT, LAS float* scr, int k0, int n0, int drow0, int lane) {
#pragma unroll 8
    for (int i = 0; i < 32; ++i) { const int kk = 2 * i + (lane >> 5); scr[kk * 33 + (lane & 31)] = W[(size_t)(k0 + kk) * N + n0 + (lane & 31)]; }
    LDS_WAIT(); asm volatile("" ::: "memory");
    const int c = lane & 7;
#pragma unroll
    for (int j = 0; j < 4; ++j) { const int n = (lane >> 3) + 8 * j; const LAS float* s = scr + (8 * c) * 33 + n;
        v4u o; o.x = pk2(s[0 * 33], s[1 * 33]); o.y = pk2(s[2 * 33], s[3 * 33]); o.z = pk2(s[4 * 33], s[5 * 33]); o.w = pk2(s[6 * 33], s[7 * 33]);
        *(GAS v4u*)(WT + (size_t)(drow0 + n) * K + k0 + 8 * c) = o; }
    LDS_WAIT(); asm volatile("" ::: "memory");
}
__device__ __forceinline__ int glu_perm(int n) { return n < 512 ? (n >> 7) * 256 + (n & 127) : ((n - 512) >> 7) * 256 + 128 + ((n - 512) & 127); }

__device__ __forceinline__ void branch_norm(const float* src, const float* gg, bf16* Y2, int coff, int gw, int NGW, int lane) {
    for (int m = gw; m < MT; m += NGW) {
        const f32x4 a = *((const f32x4*)(src + (size_t)m * 512) + lane), b = *((const f32x4*)(src + (size_t)m * 512) + 64 + lane);
        const float s = (a.x * a.x + a.y * a.y) + (a.z * a.z + a.w * a.w) + (b.x * b.x + b.y * b.y) + (b.z * b.z + b.w * b.w);
        const float rs = 1.0f / sqrtf(wave_sum(s) * (1.f / 512) + RMS_EPS);
        const f32x4 g0 = *((const f32x4*)gg + lane), g1 = *((const f32x4*)gg + 64 + lane);
        unsigned long long* o8 = (unsigned long long*)(Y2 + (size_t)m * DM + coff);
        o8[lane] = (unsigned long long)pk2(a.x * rs * g0.x, a.y * rs * g0.y) | ((unsigned long long)pk2(a.z * rs * g0.z, a.w * rs * g0.w) << 32);
        o8[64 + lane] = (unsigned long long)pk2(b.x * rs * g1.x, b.y * rs * g1.y) | ((unsigned long long)pk2(b.z * rs * g1.z, b.w * rs * g1.w) << 32);
    }
}

__global__ void __launch_bounds__(NTHR, 2) fwd(Args args) {
    extern __shared__ __attribute__((aligned(16))) unsigned char lds[];
    LAS unsigned char* L = (LAS unsigned char*)lds;
    const int tid = threadIdx.x, lane = tid & 63, wave = __builtin_amdgcn_readfirstlane(tid >> 6);
    const int G = gridDim.x, gw = blockIdx.x * NWAVES + wave, NGW = G * NWAVES, gt = blockIdx.x * NTHR + tid, NGT = G * NTHR;
    unsigned char* ws = args.ws; float* out = args.out;
    bf16* Win_t = (bf16*)(ws + WS_WIN); bf16* Wglu_t = (bf16*)(ws + WS_WGLU); bf16* Wout_t = (bf16*)(ws + WS_WOUT);
    bf16* XN = (bf16*)(ws + WS_XN); bf16* PROJ = (bf16*)(ws + WS_PROJ); bf16* GB = (bf16*)(ws + WS_G); bf16* Y2 = (bf16*)(ws + WS_Y2);
    float* YAR = (float*)(ws + WS_YAR); float* YSR = (float*)(ws + WS_YSR); f32x2* XST = (f32x2*)(ws + WS_XST);
    const int lo = args.ph_lo, hi = args.ph_hi;
#define IN(k) (lo <= (k) && (k) < hi)
#define SEAM(k) do { if (IN(k) && IN((k) + 1)) xcd_barrier(bar); } while (0)
    gu32* ctl = (gu32*)(ws + WS_CTL);
    for (int u = tid; u < (LDS_BYTES - LDSCTL_OFF) / 4; u += NTHR) ((LAS unsigned*)(L + LDSCTL_OFF))[u] = 0u;
    __syncthreads();
    XcdBarrier bar; bar.bar = (unsigned*)(ctl + CW_BAR); bar.x = 0; bar.st = nullptr;
    if (hi - lo > 1) bar = xcd_barrier_post((unsigned*)(ctl + CW_BAR), (volatile LAS unsigned*)(L + MISC_OFF) + 8);

    if (IN(0)) {
        LAS float* scr = (LAS float*)(L + RING_OFF + wave * 16384);
        constexpr int I_A = 16 * 96, I_B = 8 * 32, I_C = 16 * 32;
        for (int it = gw; it < I_A + I_B + I_C; it += NGW) {
            int r = it;
            if (r < I_A) { const int kb = r / 96, nb = r % 96; p0_transpose_item(args.in[I_WIN], 1024, 3072, Win_t, scr, 64 * kb, 32 * nb, 32 * nb, lane); continue; } r -= I_A;
            if (r < I_B) { const int kb = r / 32, nb = r % 32; p0_transpose_item(args.in[I_WGLU], 512, 1024, Wglu_t, scr, 64 * kb, 32 * nb, glu_perm(32 * nb), lane); continue; } r -= I_B;
            { const int kb = r / 32, nb = r % 32; p0_transpose_item(args.in[I_WOUT], 1024, 1024, Wout_t, scr, 64 * kb, 32 * nb, 32 * nb, lane); }
        }
        const float* gin = args.in[I_GIN];
        for (int m = gw; m < MT; m += NGW) {
            const float* xrow = (m < MP) ? args.in[I_XP] + (size_t)m * DM : args.in[I_XS] + (size_t)(m - MP) * DM;
            const GAS f32x4* xr = (const GAS f32x4*)xrow + lane;
            f32x4 v[4]; float s = 0.f;
#pragma unroll
            for (int j = 0; j < 4; ++j) { v[j] = xr[64 * j]; s += (v[j].x * v[j].x + v[j].y * v[j].y) + (v[j].z * v[j].z + v[j].w * v[j].w); }
            const float rs = 1.0f / sqrtf(wave_sum(s) * (1.f / DM) + RMS_EPS);
            GAS unsigned long long* o8 = (GAS unsigned long long*)(XN + (size_t)m * DM) + lane;
#pragma unroll
            for (int j = 0; j < 4; ++j) { const f32x4 g4 = *((const f32x4*)gin + lane + 64 * j);
                o8[64 * j] = (unsigned long long)pk2(v[j].x * rs * g4.x, v[j].y * rs * g4.y) | ((unsigned long long)pk2(v[j].z * rs * g4.z, v[j].w * rs * g4.w) << 32); }
        }
    }
    SEAM(0);
    if (IN(1)) {
        pg8::Gemm g{XN, Win_t, MT, NPROJ, DM}; pg8::StaticOrder S; S.init(MT, NPROJ, G, (int)blockIdx.x);
        pg8::EpiProj E{PROJ, out};
        pg8::gemm_phase<pg8::EpiProj, pg8::StaticOrder, true, true>(L + RING_OFF, g, S, E);
    }
    SEAM(1);
    if (IN(2)) {
        for (int id = gt; id < 136 * 2048; id += NGT) {
            const int p = id & 63, g = (id >> 6) & 31, seq = id >> 11;
            const float dt = expf(args.in[I_LDT][g]), are = args.in[I_ARE][g * 64 + p], aim = args.in[I_AIM][g * 64 + p];
            const float mag = expf(are * dt); float sn, cs; sincos_(aim * dt, sn, cs);
            const float lr = mag * cs, li = mag * sn, den = are * are + aim * aim;
            const float fre = ((lr - 1.0f) * are + li * aim) / den, fim = (li * are - (lr - 1.0f) * aim) / den;
            float bre[16], bim[16];
#pragma unroll
            for (int c = 0; c < 16; ++c) { const float br = args.in[I_BRE][(g * 64 + p) * 16 + c], bi = args.in[I_BIM][(g * 64 + p) * 16 + c]; bre[c] = fre * br - fim * bi; bim[c] = fre * bi + fim * br; }
            int T, rowbase; float xr, xi;
            if (seq < 8) { T = 2048; rowbase = seq * 2048; xr = 0.f; xi = 0.f; }
            else { T = 4; rowbase = MP + (seq - 8) * 4; xr = args.in[I_SRE][((seq - 8) * 32 + g) * 64 + p]; xi = args.in[I_SIM][((seq - 8) * 32 + g) * 64 + p]; }
            for (int t = 0; t < T; ++t) {
                const v4u* up = (const v4u*)(PROJ + (size_t)(rowbase + t) * NPROJ + g * 16);
                const v4u u0 = up[0], u1 = up[1];
                const float u[16] = {bflo(u0.x), bfhi(u0.x), bflo(u0.y), bfhi(u0.y), bflo(u0.z), bfhi(u0.z), bflo(u0.w), bfhi(u0.w),
                                     bflo(u1.x), bfhi(u1.x), bflo(u1.y), bfhi(u1.y), bflo(u1.z), bfhi(u1.z), bflo(u1.w), bfhi(u1.w)};
                float bur = 0.f, bui = 0.f;
#pragma unroll
                for (int c = 0; c < 16; ++c) { bur = fmaf(bre[c], u[c], bur); bui = fmaf(bim[c], u[c], bui); }
                const float nr = lr * xr - li * xi + bur, ni = lr * xi + li * xr + bui; xr = nr; xi = ni;
                XST[(size_t)(rowbase + t) * 2048 + g * 64 + p] = (f32x2){xr, xi};
            }
            if (seq < 8) { out[O_RP + (seq * 32 + g) * 64 + p] = xr; out[O_IP + (seq * 32 + g) * 64 + p] = xi; }
            else { out[O_RS + ((seq - 8) * 32 + g) * 64 + p] = xr; out[O_IS + ((seq - 8) * 32 + g) * 64 + p] = xi; }
        }
    }
    SEAM(2);
    if (IN(3)) {
        for (int id = gt; id < MT * 512; id += NGT) {
            const int ch = id & 511, m = id >> 9, g = ch >> 4, c = ch & 15;
            const f32x2* xs = XST + (size_t)m * 2048 + g * 64;
            const float* cre = args.in[I_CRE] + (g * 16 + c) * 64; const float* cim = args.in[I_CIM] + (g * 16 + c) * 64;
            float y = 0.f;
            for (int p = 0; p < 64; ++p) { const f32x2 x = xs[p]; y += cre[p] * x.x - cim[p] * x.y; }
            y += args.in[I_D][ch] * bf2f(PROJ[(size_t)m * NPROJ + ch]);
            GB[(size_t)m * 512 + ch] = (bf16)f2bf(gelu_tanh(y));
        }
    }
    SEAM(3);
    if (IN(4)) {
        for (int it = gw; it < MT * 8; it += NGW) {
            const int m = it >> 3, h = it & 7;
            const float qe = bf2f(PROJ[(size_t)m * NPROJ + 1024 + h * 64 + lane]) * 0.125f;
            const bool prompt = m < MP;
            const int b = m >> 11, t = m & 2047, n = (m - MP) >> 2, j = (m - MP) & 3;
            float om[3], ol[3], oo[3];
#pragma unroll
            for (int pi = 0; pi < 3; ++pi) {
                const int d = (pi == 0) ? 1 : (pi == 1) ? 4 : 16;
                float mx = -INFINITY, l = 0.f, acc = 0.f;
                for (int i = 0; i <= 128; ++i) {
                    float kv, vv;
                    if (prompt) { const int tk = t - d * i; if (tk < 0) break;
                        const bf16* rp = PROJ + (size_t)(b * 2048 + tk) * NPROJ + h * 64 + lane; kv = bf2f(rp[1536]); vv = bf2f(rp[2048]); }
                    else { const int pos = 2048 + j - d * i;
                        if (pos >= 2048) { const bf16* rp = PROJ + (size_t)(MP + n * 4 + (pos - 2048)) * NPROJ + h * 64 + lane; kv = bf2f(rp[1536]); vv = bf2f(rp[2048]); }
                        else { const size_t o = (((size_t)n * 2048 + pos) * 8 + h) * 64 + lane; kv = args.in[I_CK][o]; vv = args.in[I_CV][o]; } }
                    const float s = wave_sum(qe * kv);
                    const float mn = fmaxf(mx, s), sc = expf(mx - mn), pe = expf(s - mn);
                    l = l * sc + pe; acc = acc * sc + pe * vv; mx = mn;
                }
                om[pi] = mx; ol[pi] = l; oo[pi] = acc;
            }
            const float bm = fmaxf(om[0], fmaxf(om[1], om[2]));
            const float w0 = expf(om[0] - bm), w1 = expf(om[1] - bm), w2 = expf(om[2] - bm);
            const float num = w0 * oo[0] + w1 * oo[1] + w2 * oo[2], dn = w0 * ol[0] + w1 * ol[1] + w2 * ol[2];
            const float za = bf2f(PROJ[(size_t)m * NPROJ + 2560 + h * 64 + lane]);
            YAR[(size_t)m * 512 + h * 64 + lane] = (num / dn) * silu_(za);
        }
    }
    SEAM(4);
    if (IN(5)) branch_norm(YAR, args.in[I_GA], Y2, 512, gw, NGW, lane);
    SEAM(5);
    if (IN(6)) {
        pg8::Gemm g{GB, Wglu_t, MT, 1024, 512}; pg8::StaticOrder S; S.init(MT, 1024, G, (int)blockIdx.x);
        pg8::EpiGlu E{PROJ, args.in[I_BGLU], YSR};
        pg8::gemm_phase<pg8::EpiGlu, pg8::StaticOrder, true, true>(L + RING_OFF, g, S, E);
    }
    SEAM(6);
    if (IN(7)) branch_norm(YSR, args.in[I_GS], Y2, 0, gw, NGW, lane);
    SEAM(7);
    if (IN(8)) {
        pg8::Gemm g{Y2, Wout_t, MT, DM, DM}; pg8::StaticOrder S; S.init(MT, DM, G, (int)blockIdx.x);
        pg8::EpiOut E{args.in[I_XP], args.in[I_XS], out};
        pg8::gemm_phase<pg8::EpiOut, pg8::StaticOrder, true, true>(L + RING_OFF, g, S, E);
    }
    SEAM(8);
    if (IN(9)) {
        const float* gf = args.in[I_GF];
        for (int m = gw; m < MT; m += NGW) {
            GAS f32x4* yr = (GAS f32x4*)(out + O_YP + (size_t)m * DM) + lane;
            f32x4 v[4]; float s = 0.f;
#pragma unroll
            for (int j = 0; j < 4; ++j) { v[j] = yr[64 * j]; s += (v[j].x * v[j].x + v[j].y * v[j].y) + (v[j].z * v[j].z + v[j].w * v[j].w); }
            const float rs = 1.0f / sqrtf(wave_sum(s) * (1.f / DM) + RMS_EPS);
#pragma unroll
            for (int j = 0; j < 4; ++j) { const f32x4 g4 = *((const f32x4*)gf + lane + 64 * j); yr[64 * j] = v[j] * rs * g4; }
        }
    }
#undef IN
#undef SEAM
}

extern "C" void kernel_launch(void* const* d_in, const int* in_sizes, int n_in, void* d_out, int out_size, void* d_ws, size_t ws_size, hipStream_t stream) {
    static int grid = 0;
    if (grid == 0) {
        if (n_in != 22 || out_size != (int)O_END || ws_size < WS_END) { fprintf(stderr, "kernel_launch: unexpected shapes n_in %d out %d ws %zu\n", n_in, out_size, ws_size); grid = -1; return; }
        int dev = 0, cus = 0, per_cu = 0;
        if (hipGetDevice(&dev) != hipSuccess || hipDeviceGetAttribute(&cus, hipDeviceAttributeMultiprocessorCount, dev) != hipSuccess) { grid = -1; return; }
        if (hipFuncSetAttribute((const void*)fwd, hipFuncAttributeMaxDynamicSharedMemorySize, LDS_BYTES) != hipSuccess) { fprintf(stderr, "kernel_launch: hipFuncSetAttribute failed\n"); grid = -1; return; }
        if (hipOccupancyMaxActiveBlocksPerMultiprocessor(&per_cu, (const void*)fwd, NTHR, LDS_BYTES) != hipSuccess || per_cu < 1) fprintf(stderr, "kernel_launch: occupancy query says %d\n", per_cu);
        (void)hipGetLastError();
        grid = cus;
    }
    if (grid < 0) return;
    (void)hipMemsetAsync((char*)d_ws + WS_CTL, 0, CTL_ZERO_BYTES, stream);
    Args a{};
    for (int i = 0; i < 22; ++i) a.in[i] = (const float*)d_in[i];
    a.out = (float*)d_out; a.ws = (unsigned char*)d_ws;
#if defined(MK_PER_PHASE)
    for (int ph = 0; ph < NPHASE; ++ph) { a.ph_lo = ph; a.ph_hi = ph + 1; hipLaunchKernelGGL(fwd, dim3(grid), dim3(NTHR), LDS_BYTES, stream, a); }
#else
    a.ph_lo = 0; a.ph_hi = NPHASE;
    hipLaunchKernelGGL(fwd, dim3(grid), dim3(NTHR), LDS_BYTES, stream, a);
#endif
}
```

```cpp
#include <hip/hip_runtime.h>
#include <cstdio>
#include <cstdint>
constexpr size_t O_YP = 0, O_YS = 16777216, O_KP = 17301504, O_VP = 25690112, O_RP = 34078720, O_IP = 34095104,
                 O_KS = 34111488, O_VS = 34373632, O_RS = 34635776, O_IS = 34897920, O_END = 35160064;
constexpr int MP = 16384, MS = 512, MT = MP + MS;
constexpr int DM = 1024, NPROJ = 3072;
namespace pg8 {
#define PG8_LAS __attribute__((address_space(3)))
typedef unsigned short bf16_t;
typedef short bf16x8 __attribute__((ext_vector_type(8)));
typedef float f32x4 __attribute__((ext_vector_type(4)));
typedef unsigned u32x4 __attribute__((ext_vector_type(4)));
constexpr int BM = 256, BK = 64, HALF = 128, HTB = HALF * BK * 2  , STAGE_BYTES = 8 * HTB, NXCD = 8, WGM = 8;

__host__ __device__ __forceinline__ int lds_byte(int r, int c) { const int st = (r >> 4) * 2 + (c >> 5), rr = r & 15, cc = c & 31, ob = rr * 64 + cc * 2; return st * 1024 + (ob ^ (((ob >> 9) & 1) << 5)); }
__host__ __device__ __forceinline__ void stage_rc(int b, int& R, int& C) { const int st = b / 1024, sb = b % 1024, swz = sb ^ (((sb >> 9) & 1) << 5); R = (st >> 1) * 16 + swz / 64; C = (st & 1) * 32 + (swz % 64) / 2; }
__host__ __device__ __forceinline__ int perm32(int rho) { const int n = rho >> 4, i = rho & 15; return 8 * (i >> 2) + 4 * n + (i & 3); }

struct Unit { int pm, pn; };
struct Gemm { const bf16_t* A; const bf16_t* Bt; int M, N, K; };

struct StaticOrder {
    int nM, nN, nwg, G, c;
    __host__ __device__ void init(int M, int N, int G_, int c_) { nM = M / BM; nN = N / BM; nwg = nM * nN; G = G_; c = c_; }
    __host__ __device__ bool next(int i, Unit& u) const {
        const long L = (long)i * G + c; if (L >= nwg) return false;
        int wgid = (int)L; { const int q = nwg / NXCD, r = nwg % NXCD, xcd = wgid % NXCD, off = wgid / NXCD; wgid = (xcd < r ? xcd * (q + 1) : r * (q + 1) + (xcd - r) * q) + off; }
        const int nig = WGM * nN, gid = wgid / nig, fm = gid * WGM, gsz = (nM - fm) < WGM ? (nM - fm) : WGM;
        u.pm = fm + ((wgid % nig) % gsz); u.pn = (wgid % nig) / gsz; return true;
    }
    __device__ __forceinline__ void a_ready(const Unit&) const {}
    __device__ __forceinline__ void done(const Unit&) const {}
};

__device__ __forceinline__ unsigned cvt_pk_bf16(float lo, float hi) { unsigned r; asm volatile("v_cvt_pk_bf16_f32 %0, %1, %2" : "=v"(r) : "v"(lo), "v"(hi)); return r; }
typedef float f32x2 __attribute__((ext_vector_type(2)));
typedef unsigned u32x4 __attribute__((ext_vector_type(4)));
__device__ __forceinline__ float bf2f(unsigned short u) { return __uint_as_float(((unsigned)u) << 16); }
__device__ __forceinline__ float bflo(unsigned w) { return __uint_as_float(w << 16); }
__device__ __forceinline__ float bfhi(unsigned w) { return __uint_as_float(w & 0xffff0000u); }
__device__ __forceinline__ float sigmoidf_(float x) { return 1.0f / (1.0f + __expf(-x)); }
struct EpiProj {
    static constexpr bool PERM = true, AFTER_DRAIN = false;
    bf16_t* P; float* out;
    __device__ __forceinline__ void operator()(const f32x4 (&acc)[2][2][4][2], const Unit& u, int wr, int wc, int fr, int fq) const {
        const int row0 = u.pm * BM + wr * 64 + fr, col0 = u.pn * BM + wc * 32 + 8 * fq;
        float* fo = nullptr;
        if (u.pn >= 6 && u.pn < 10) {
            const bool isv = u.pn >= 8; const int cb = isv ? 2048 : 1536;
            if (u.pm < 64) fo = out + (isv ? O_VP : O_KP) + (size_t)row0 * 512 + (col0 - cb);
            else           fo = out + (isv ? O_VS : O_KS) + (size_t)(row0 - MP) * 512 + (col0 - cb);
        }
#pragma unroll
        for (int ai = 0; ai < 2; ++ai)
#pragma unroll
            for (int m = 0; m < 4; ++m) {
                const int rr = ai * HALF + m * 16;
                bf16_t* rowp = P + (size_t)(row0 + rr) * NPROJ + col0;
#pragma unroll
                for (int bj = 0; bj < 2; ++bj) {
                    const f32x4 v0 = acc[ai][bj][m][0], v1 = acc[ai][bj][m][1];
                    u32x4 w; w.x = cvt_pk_bf16(v0[0], v0[1]); w.y = cvt_pk_bf16(v0[2], v0[3]); w.z = cvt_pk_bf16(v1[0], v1[1]); w.w = cvt_pk_bf16(v1[2], v1[3]);
                    *(u32x4*)(rowp + bj * HALF) = w;
                    if (fo) { float* f = fo + (size_t)rr * 512 + bj * HALF; *(f32x4*)f = v0; *(f32x4*)(f + 4) = v1; }
                }
            }
    }
};
struct EpiGlu {
    static constexpr bool PERM = true, AFTER_DRAIN = false;
    const bf16_t* P; const float* bglu; float* YSR;
    __device__ __forceinline__ void operator()(const f32x4 (&acc)[2][2][4][2], const Unit& u, int wr, int wc, int fr, int fq) const {
        const int row0 = u.pm * BM + wr * 64 + fr, cv0 = u.pn * HALF + wc * 32 + 8 * fq;
        const f32x4 bv0 = *(const f32x4*)(bglu + cv0), bv1 = *(const f32x4*)(bglu + cv0 + 4), bg0 = *(const f32x4*)(bglu + 512 + cv0), bg1 = *(const f32x4*)(bglu + 512 + cv0 + 4);
#pragma unroll
        for (int ai = 0; ai < 2; ++ai)
#pragma unroll
            for (int m = 0; m < 4; ++m) {
                const int row = row0 + ai * HALF + m * 16;
                const u32x4 zw = *(const u32x4*)(P + (size_t)row * NPROJ + 512 + cv0);
                const float z[8] = {bflo(zw.x), bfhi(zw.x), bflo(zw.y), bfhi(zw.y), bflo(zw.z), bfhi(zw.z), bflo(zw.w), bfhi(zw.w)};
                f32x4 o0, o1;
#pragma unroll
                for (int i = 0; i < 4; ++i) {
                    const float va = acc[ai][0][m][0][i] + bv0[i], ga = acc[ai][1][m][0][i] + bg0[i];
                    const float vb = acc[ai][0][m][1][i] + bv1[i], gb = acc[ai][1][m][1][i] + bg1[i];
                    o0[i] = va * sigmoidf_(ga) * (z[i] * sigmoidf_(z[i]));
                    o1[i] = vb * sigmoidf_(gb) * (z[4 + i] * sigmoidf_(z[4 + i]));
                }
                float* yp = YSR + (size_t)row * 512 + cv0; *(f32x4*)yp = o0; *(f32x4*)(yp + 4) = o1;
            }
    }
};
struct EpiOut {
    static constexpr bool PERM = false, AFTER_DRAIN = false;
    const float* xp; const float* xs; float* out;
    __device__ __forceinline__ void operator()(const f32x4 (&acc)[2][2][4][2], const Unit& u, int wr, int wc, int fr, int fq) const {
        const int row0 = u.pm * BM + wr * 64 + fr, col0 = u.pn * BM + wc * 32 + 4 * fq;
        const float* xb = (u.pm < 64) ? xp + (size_t)row0 * DM : xs + (size_t)(row0 - MP) * DM;
        float* ob = out + O_YP + (size_t)row0 * DM;
#pragma unroll
        for (int ai = 0; ai < 2; ++ai)
#pragma unroll
            for (int m = 0; m < 4; ++m) {
                const size_t ro = (size_t)(ai * HALF + m * 16) * DM + col0;
#pragma unroll
                for (int bj = 0; bj < 2; ++bj)
#pragma unroll
                    for (int n = 0; n < 2; ++n) { const size_t o = ro + bj * HALF + n * 16; *(f32x4*)(ob + o) = *(const f32x4*)(xb + o) + acc[ai][bj][m][n]; }
            }
    }
};
template <class Epi, class Sched, bool ALIGN_EPI = false, bool SP2 = false>
__device__ __forceinline__ void gemm_phase(PG8_LAS unsigned char* lds, const Gemm g, const Sched& S, const Epi& E) {
    const int tid = threadIdx.x, wid = __builtin_amdgcn_readfirstlane(tid >> 6), lane = tid & 63, wr = wid >> 2, wc = wid & 3, fr = lane & 15, fq = lane >> 4;
    const int K = g.K, nt = K / BK;
    unsigned voffA[2], voffB[2];
#pragma unroll
    for (int i = 0; i < 2; ++i) { int R, C; stage_rc(tid * 16 + i * 8192, R, C); const int Rb = Epi::PERM ? ((R & ~31) + perm32(R & 31)) : R;
        voffA[i] = (unsigned)(R * K + C) * 2u; voffB[i] = (unsigned)(Rb * K + C) * 2u; }
    const size_t kstep = (size_t)(BK * 2);
    const size_t hstep = (size_t)HALF * K * 2;
    const size_t tstep = 2 * hstep;
    const unsigned ldsw = (unsigned)wid * 1024u;
    const int aoff = lds_byte(wr * 64 + fr, fq * 8), boff = lds_byte(wc * 32 + fr, fq * 8);
#define PG8_SA(b, h) (((b) * 2 + (h)) * HTB)
#define PG8_SB(b, h) ((4 + (b) * 2 + (h)) * HTB)
#define PG8_STAGE(bufoff, gbase, voff) do { _Pragma("unroll") for (int _i = 0; _i < 2; ++_i) \
        __builtin_amdgcn_global_load_lds((const unsigned*)((const char*)(gbase) + (voff)[_i]), (PG8_LAS unsigned*)(lds + (bufoff) + ldsw + _i * 8192), 16, 0, 0); } while (0)
#define PG8_LDA(dst, b, h) do { _Pragma("unroll") for (int m = 0; m < 4; ++m) _Pragma("unroll") for (int k = 0; k < 2; ++k) dst[m][k] = *(const PG8_LAS bf16x8*)(lds + PG8_SA(b, h) + aoff + m * 2048 + k * 1024); } while (0)
#define PG8_LDB(dst, b, h) do { _Pragma("unroll") for (int n = 0; n < 2; ++n) _Pragma("unroll") for (int k = 0; k < 2; ++k) dst[n][k] = *(const PG8_LAS bf16x8*)(lds + PG8_SB(b, h) + boff + n * 2048 + k * 1024); } while (0)
#define PG8_MMA(ai, bj, At, Bt) do { __builtin_amdgcn_s_setprio(1); _Pragma("unroll") for (int m = 0; m < 4; ++m) _Pragma("unroll") for (int n = 0; n < 2; ++n) _Pragma("unroll") for (int k = 0; k < 2; ++k) \
        acc[ai][bj][m][n] = __builtin_amdgcn_mfma_f32_16x16x32_bf16(Bt[n][k], At[m][k], acc[ai][bj][m][n], 0, 0, 0); __builtin_amdgcn_s_setprio(0); } while (0)
#define PG8_WAIT_V(n) asm volatile("s_waitcnt vmcnt(" #n ")" ::: "memory")
#define PG8_WAIT_L(n) asm volatile("s_waitcnt lgkmcnt(" #n ")" ::: "memory")
#define PG8_BAR __builtin_amdgcn_s_barrier()
#define PG8_SCHED __builtin_amdgcn_sched_barrier(0)
    Unit cur, nxt; int ui = 0;
    if (!S.next(0, cur)) return;
    f32x4 acc[2][2][4][2];
#pragma unroll
    for (int a = 0; a < 2; ++a)
#pragma unroll
        for (int b = 0; b < 2; ++b)
#pragma unroll
            for (int m = 0; m < 4; ++m)
#pragma unroll
                for (int n = 0; n < 2; ++n) acc[a][b][m][n] = (f32x4){0.f, 0.f, 0.f, 0.f};
    bf16x8 At[4][2], B0[2][2], B1[2][2];
    const char* cA = (const char*)g.A + (size_t)cur.pm * tstep; const char* cB = (const char*)g.Bt + (size_t)cur.pn * tstep;
    S.a_ready(cur);
    if constexpr (SP2) {
        PG8_STAGE(PG8_SB(0, 0), cB, voffB); PG8_STAGE(PG8_SB(0, 1), cB + hstep, voffB); PG8_STAGE(PG8_SA(0, 0), cA, voffA); PG8_STAGE(PG8_SA(0, 1), cA + hstep, voffA);
        if (wr == 1) PG8_BAR;
        PG8_WAIT_V(2); PG8_BAR;
        PG8_STAGE(PG8_SB(1, 0), cB + kstep, voffB); PG8_STAGE(PG8_SA(1, 0), cA + kstep, voffA); PG8_STAGE(PG8_SB(1, 1), cB + hstep + kstep, voffB);
        PG8_WAIT_V(6); PG8_BAR;
    } else {
        PG8_STAGE(PG8_SB(0, 0), cB, voffB); PG8_STAGE(PG8_SA(0, 0), cA, voffA); PG8_STAGE(PG8_SB(0, 1), cB + hstep, voffB); PG8_STAGE(PG8_SA(0, 1), cA + hstep, voffA);
        if (wr == 1) PG8_BAR;
        PG8_WAIT_V(4); PG8_BAR;
        PG8_STAGE(PG8_SB(1, 0), cB + kstep, voffB); PG8_STAGE(PG8_SA(1, 0), cA + kstep, voffA); PG8_STAGE(PG8_SB(1, 1), cB + hstep + kstep, voffB);
        PG8_WAIT_V(6); PG8_BAR;
    }
    for (;;) {
        const bool has_next = S.next(ui + 1, nxt);
        const char* nA = has_next ? (const char*)g.A + (size_t)nxt.pm * tstep : cA; const char* nB = has_next ? (const char*)g.Bt + (size_t)nxt.pn * tstep : cB;
        for (int t = 0; t < nt; t += 2) {
            const bool last = (t == nt - 2);
            const char* a1 = cA + (size_t)(t + 1) * kstep;
            const char* a2 = last ? nA : cA + (size_t)(t + 2) * kstep; const char* b2 = last ? nB : cB + (size_t)(t + 2) * kstep;
            const char* a3 = a2 + kstep; const char* b3 = b2 + kstep;
            if (last && has_next) S.a_ready(nxt);
            if constexpr (SP2) {
            PG8_LDB(B0, 0, 0); PG8_LDB(B1, 0, 1); PG8_SCHED; PG8_LDA(At, 0, 0); PG8_STAGE(PG8_SA(1, 1), a1 + hstep, voffA);
            PG8_WAIT_V(8); PG8_WAIT_L(0); PG8_BAR; PG8_MMA(0, 0, At, B0); PG8_MMA(0, 1, At, B1); PG8_BAR; PG8_SCHED;
            PG8_LDA(At, 0, 1); PG8_STAGE(PG8_SB(0, 0), b2, voffB); PG8_STAGE(PG8_SB(0, 1), b2 + hstep, voffB); PG8_STAGE(PG8_SA(0, 0), a2, voffA);
            PG8_WAIT_V(8); PG8_WAIT_L(0); PG8_BAR; PG8_MMA(1, 0, At, B0); PG8_MMA(1, 1, At, B1); PG8_BAR; PG8_SCHED;
            PG8_LDB(B0, 1, 0); PG8_LDB(B1, 1, 1); PG8_SCHED; PG8_LDA(At, 1, 0); PG8_STAGE(PG8_SA(0, 1), a2 + hstep, voffA);
            PG8_WAIT_V(8); PG8_WAIT_L(0); PG8_BAR; PG8_MMA(0, 0, At, B0); PG8_MMA(0, 1, At, B1); PG8_BAR; PG8_SCHED;
            PG8_LDA(At, 1, 1); PG8_STAGE(PG8_SB(1, 0), b3, voffB); PG8_STAGE(PG8_SB(1, 1), b3 + hstep, voffB); PG8_STAGE(PG8_SA(1, 0), a3, voffA);
            PG8_WAIT_V(8); PG8_WAIT_L(0); PG8_BAR; PG8_MMA(1, 0, At, B0); PG8_MMA(1, 1, At, B1); PG8_BAR; PG8_SCHED;
            } else {
            PG8_LDB(B0, 0, 0); PG8_SCHED; PG8_LDA(At, 0, 0); PG8_STAGE(PG8_SA(1, 1), a1 + hstep, voffA);
            PG8_WAIT_L(8); PG8_BAR; PG8_WAIT_L(0); PG8_MMA(0, 0, At, B0); PG8_BAR; PG8_SCHED;
            PG8_LDB(B1, 0, 1); PG8_STAGE(PG8_SB(0, 0), b2, voffB);
            PG8_BAR; PG8_WAIT_L(0); PG8_MMA(0, 1, At, B1); PG8_BAR;
            PG8_LDA(At, 0, 1); PG8_STAGE(PG8_SA(0, 0), a2, voffA);
            PG8_BAR; PG8_WAIT_L(0); PG8_MMA(1, 0, At, B0); PG8_BAR; PG8_SCHED;
            PG8_STAGE(PG8_SB(0, 1), b2 + hstep, voffB);
            PG8_WAIT_V(6); PG8_BAR; PG8_MMA(1, 1, At, B1); PG8_BAR;
            PG8_LDB(B0, 1, 0); PG8_SCHED; PG8_LDA(At, 1, 0); PG8_STAGE(PG8_SA(0, 1), a2 + hstep, voffA);
            PG8_WAIT_L(8); PG8_BAR; PG8_WAIT_L(0); PG8_MMA(0, 0, At, B0); PG8_BAR; PG8_SCHED;
            PG8_LDB(B1, 1, 1); PG8_STAGE(PG8_SB(1, 0), b3, voffB);
            PG8_BAR; PG8_WAIT_L(0); PG8_MMA(0, 1, At, B1); PG8_BAR;
            PG8_LDA(At, 1, 1); PG8_STAGE(PG8_SA(1, 0), a3, voffA);
            PG8_BAR; PG8_WAIT_L(0); PG8_MMA(1, 0, At, B0); PG8_BAR; PG8_SCHED;
            PG8_STAGE(PG8_SB(1, 1), b3 + hstep, voffB);
            PG8_WAIT_V(6); PG8_BAR; PG8_MMA(1, 1, At, B1); PG8_BAR;
            }
        }
        if constexpr (ALIGN_EPI) { if (wr == 0) PG8_BAR; }
        if constexpr (!Epi::AFTER_DRAIN) { E(acc, cur, wr, wc, fr, fq); S.done(cur); }
        if (!has_next) break;
#pragma unroll
        for (int a = 0; a < 2; ++a)
#pragma unroll
            for (int b = 0; b < 2; ++b)
#pragma unroll
                for (int m = 0; m < 4; ++m)
#pragma unroll
                    for (int n = 0; n < 2; ++n) acc[a][b][m][n] = (f32x4){0.f, 0.f, 0.f, 0.f};
        cur = nxt; cA = nA; cB = nB; ++ui;
        if constexpr (ALIGN_EPI) { if (wr == 1) PG8_BAR; }
    }
    PG8_WAIT_V(0);
    if constexpr (!ALIGN_EPI) { if (wr == 0) PG8_BAR; }
    PG8_BAR;
    if constexpr (Epi::AFTER_DRAIN) { E.fused(acc, cur, wr, wc, fr, fq, lds, wid, lane); S.done(cur); }
#undef PG8_SA
#undef PG8_SB
#undef PG8_STAGE
#undef PG8_LDA
#undef PG8_LDB
#undef PG8_MMA
#undef PG8_WAIT_V
#undef PG8_WAIT_L
#undef PG8_BAR
#undef PG8_SCHED
}
}
#define PG8_UNUSED 0
#define GAS __attribute__((address_space(1)))
#define LAS __attribute__((address_space(3)))
typedef unsigned short bf16;
typedef unsigned v4u __attribute__((ext_vector_type(4)));
typedef float f32x4 __attribute__((ext_vector_type(4)));
typedef short bf16x8 __attribute__((ext_vector_type(8)));
typedef GAS unsigned gu32;
typedef GAS unsigned long long gu64;
#define RLX_AGENT __ATOMIC_RELAXED, __HIP_MEMORY_SCOPE_AGENT
#define LDS_WAIT() asm volatile("s_waitcnt lgkmcnt(0)" ::: "memory")
#define VM_WAIT() asm volatile("s_waitcnt vmcnt(0)" ::: "memory")
__device__ __forceinline__ unsigned long long rt() { return __builtin_amdgcn_s_memrealtime(); }
__device__ __forceinline__ unsigned f2bf(float f) { unsigned u = __builtin_bit_cast(unsigned, f); return (u + 0x7fffu + ((u >> 16) & 1u)) >> 16; }
__device__ __forceinline__ unsigned pk2(float lo, float hi) { return f2bf(lo) | (f2bf(hi) << 16); }

#define XB_TMO      128
#define XB_XCNT(j)  (256  + 64 * (j))
#define XB_XSUB(j)  (1280 + 64 * (j))
#define XB_XGEN(j)  (2304 + 64 * (j))
#define XB_TOP      3328
#define XB_TOPGEN   3392
#define XCD_BAR_WORDS 3456
#define XB_SPIN_CAP (1u << 18)

__device__ __forceinline__ unsigned xb_ld(unsigned* p)              { return __hip_atomic_load(p, __ATOMIC_RELAXED, __HIP_MEMORY_SCOPE_AGENT); }
__device__ __forceinline__ unsigned xb_add(unsigned* p, unsigned v) { return __hip_atomic_fetch_add(p, v, __ATOMIC_RELAXED, __HIP_MEMORY_SCOPE_AGENT); }
__device__ __forceinline__ unsigned xb_xcc_id() { return (unsigned)__builtin_amdgcn_s_getreg((3 << 11) | 20) & 0xFu; }
#define XB_SPIN(cond, bar) do { unsigned _sp = 0; while (cond) { __builtin_amdgcn_s_sleep(1); \
    if ((++_sp & 255u) == 0u) { if (xb_ld(&(bar)[XB_TMO])) break; if (_sp > XB_SPIN_CAP) { atomicAdd(&(bar)[XB_TMO], 1u); break; } } } } while (0)

struct XcdBarrier {
    unsigned* bar; unsigned x;
    volatile LAS unsigned* st;
};

__device__ __forceinline__ XcdBarrier xcd_barrier_post(unsigned* bar, volatile LAS unsigned* st) {
    XcdBarrier b; b.bar = bar; b.x = xb_xcc_id(); b.st = st;
    if (threadIdx.x == 0) (void)xb_add(&bar[XB_XCNT(b.x)], 1u);
    return b;
}
__device__ __forceinline__ void xcd_barrier_complete(unsigned* bar, unsigned x, unsigned& nloc, unsigned& nx) {
    const unsigned G = gridDim.x * gridDim.y * gridDim.z;
    unsigned sum, cnt, mine, sp = 0u;
    for (;;) {
        sum = 0u; cnt = 0u; mine = 0u;
#pragma unroll
        for (unsigned j = 0; j < 16; ++j) { const unsigned c = xb_ld(&bar[XB_XCNT(j)]); sum += c; cnt += (c > 0u) ? 1u : 0u; mine = (j == x) ? c : mine; }
        if (sum == G) break;
        __builtin_amdgcn_s_sleep(1);
        if ((++sp & 255u) == 0u) { if (xb_ld(&bar[XB_TMO])) break; if (sp > XB_SPIN_CAP) { atomicAdd(&bar[XB_TMO], 1u); break; } }
    }
    nloc = mine > 0u ? mine : 1u; nx = cnt > 0u ? cnt : 1u;
}

__device__ __forceinline__ void xcd_barrier(const XcdBarrier& b) {
    asm volatile("s_waitcnt vmcnt(0)" ::: "memory");
    __syncthreads();
    if (threadIdx.x == 0) {
        unsigned* bar = b.bar;
        __builtin_amdgcn_s_waitcnt(0);
        unsigned nloc = b.st[0], nx = b.st[1];
        if (nloc == 0u) { xcd_barrier_complete(bar, b.x, nloc, nx); b.st[0] = nloc; b.st[1] = nx; }
        const unsigned old = xb_add(&bar[XB_XSUB(b.x)], 1u);
        const unsigned gen = old / nloc;
        if (old + 1u == (gen + 1u) * nloc) {
            __builtin_amdgcn_fence(__ATOMIC_RELEASE, "agent");
            asm volatile("s_waitcnt vmcnt(0)" ::: "memory");
            const unsigned og = xb_add(&bar[XB_TOP], 1u);
            const unsigned tg = og / nx;
            if (og + 1u == (tg + 1u) * nx) xb_add(&bar[XB_TOPGEN], 1u);
            else XB_SPIN(xb_ld(&bar[XB_TOPGEN]) == tg, bar);
            __builtin_amdgcn_fence(__ATOMIC_ACQUIRE, "agent");
            xb_add(&bar[XB_XGEN(b.x)], 1u);
            asm volatile("s_waitcnt vmcnt(0)" ::: "memory");
        } else {
            XB_SPIN(xb_ld(&bar[XB_XGEN(b.x)]) == gen, bar);
            __builtin_amdgcn_fence(__ATOMIC_ACQUIRE, "agent");
            asm volatile("s_waitcnt vmcnt(0)" ::: "memory");
        }
    }
    __syncthreads();
}
constexpr int NWAVES = 8, NTHR = 512;
constexpr size_t MiB = 1u << 20;
constexpr size_t WS_CTL = 0, CTL_ZERO_BYTES = 1 * MiB;
constexpr size_t WS_WIN = 2 * MiB, WS_WGLU = 8 * MiB, WS_WOUT = 10 * MiB;
constexpr size_t WS_XN = 16 * MiB;
constexpr size_t WS_PROJ = 64 * MiB;
constexpr size_t WS_G = 176 * MiB;
constexpr size_t WS_Y2 = 200 * MiB;
constexpr size_t WS_YAR = 240 * MiB, WS_YSR = 280 * MiB;
constexpr size_t WS_XST = 320 * MiB;
constexpr size_t WS_OP = 600 * MiB, WS_ML = 650 * MiB, WS_SPO = 654 * MiB, WS_SPM = 661 * MiB;
constexpr size_t WS_END = 662 * MiB;
constexpr int CW_BAR = 4096;
constexpr int RING_OFF = 0, RING_BYTES = 131072, LDSCTL_OFF = RING_BYTES, MISC_OFF = LDSCTL_OFF + 320, LDS_BYTES = 147456;
constexpr float RMS_EPS = 1e-6f;
constexpr int NPHASE = 10;

typedef float f32x2 __attribute__((ext_vector_type(2)));
typedef unsigned u32x4 __attribute__((ext_vector_type(4)));
__device__ __forceinline__ float bf2f(unsigned short u) { return __uint_as_float(((unsigned)u) << 16); }
__device__ __forceinline__ float bflo(unsigned w) { return __uint_as_float(w << 16); }
__device__ __forceinline__ float bfhi(unsigned w) { return __uint_as_float(w & 0xffff0000u); }
__device__ __forceinline__ float wave_sum(float v) {
#pragma unroll
    for (int o = 1; o < 64; o <<= 1) v += __shfl_xor(v, o);
    return v;
}
__device__ __forceinline__ void sincos_(float x, float& s, float& c) {
    const float k = rintf(x * 0.63661977236758134f);
    float r = fmaf(-k, 1.5703125f, x); r = fmaf(-k, 4.837512969970703125e-4f, r); r = fmaf(-k, 7.54978995489188216e-8f, r);
    const float z = r * r;
    const float sp = r + r * z * (-1.6666654611e-1f + z * (8.3321608736e-3f + z * (-1.9515295891e-4f)));
    const float cp = 1.0f - 0.5f * z + z * z * (4.166664568298827e-2f + z * (-1.388731625493765e-3f + z * 2.443315711809948e-5f));
    const int q = ((int)k) & 3;
    const float ss = (q & 1) ? cp : sp, cc = (q & 1) ? sp : cp;
    s = (q & 2) ? -ss : ss; c = ((q + 1) & 2) ? -cc : cc;
}
__device__ __forceinline__ float gelu_tanh(float x) {
    const float z = 0.7978845608028654f * (x + 0.044715f * x * x * x);
    const float t = __expf(2.0f * z);
    const float th = 1.0f - 2.0f / (t + 1.0f);
    return 0.5f * x * (1.0f + th);
}
__device__ __forceinline__ float silu_(float z) { return z / (1.0f + __expf(-z)); }

struct Args { const float* in[22]; float* out; unsigned char* ws; int ph_lo, ph_hi; };
enum { I_XP = 0, I_XS, I_CK, I_CV, I_SRE, I_SIM, I_GIN, I_WIN, I_ARE, I_AIM, I_LDT, I_BRE, I_BIM, I_CRE, I_CIM, I_D, I_WGLU, I_BGLU, I_GS, I_GA, I_WOUT, I_GF };

__device__ __forceinline__ void p0_transpose_item(const float* W, int K, int N, bf16* WT, LAS float* scr, int k0, int n0, int drow0, int lane) {
#pragma unroll 8
    for (int i = 0; i < 32; ++i) { const int kk = 2 * i + (lane >> 5); scr[kk * 33 + (lane & 31)] = W[(size_t)(k0 + kk) * N + n0 + (lane & 31)]; }
    LDS_WAIT(); asm volatile("" ::: "memory");
    const int c = lane & 7;
#pragma unroll
    for (int j = 0; j < 4; ++j) { const int n = (lane >> 3) + 8 * j; const LAS float* s = scr + (8 * c) * 33 + n;
        v4u o; o.x = pk2(s[0 * 33], s[1 * 33]); o.y = pk2(s[2 * 33], s[3 * 33]); o.z = pk2(s[4 * 33], s[5 * 33]); o.w = pk2(s[6 * 33], s[7 * 33]);
        *(GAS v4u*)(WT + (size_t)(drow0 + n) * K + k0 + 8 * c) = o; }
    LDS_WAIT(); asm volatile("" ::: "memory");
}
__device__ __forceinline__ int glu_perm(int n) { return n < 512 ? (n >> 7) * 256 + (n & 127) : ((n - 512) >> 7) * 256 + 128 + ((n - 512) & 127); }

typedef float f32x16 __attribute__((ext_vector_type(16)));
typedef short s16x4 __attribute__((ext_vector_type(4)));
typedef short v4i16_t __attribute__((ext_vector_type(4)));
constexpr float C2LOG = 0.125f * 1.4426950408889634f;
constexpr float M_INIT = -1e30f;
__device__ __forceinline__ int crow(int r, int h2) { return (r & 3) + 8 * (r >> 2) + 4 * h2; }
__device__ __forceinline__ unsigned cvtpk(float lo, float hi) { unsigned r; asm volatile("v_cvt_pk_bf16_f32 %0, %1, %2" : "=v"(r) : "v"(lo), "v"(hi)); return r; }
__device__ __forceinline__ float ex2(float x) { return __builtin_amdgcn_exp2f(x); }
template <int CTRL> __device__ __forceinline__ float dpp_f(float v) { return __int_as_float(__builtin_amdgcn_update_dpp(0, __float_as_int(v), CTRL, 0xf, 0xf, false)); }
__device__ __forceinline__ float red16(float v) { v += dpp_f<0xB1>(v); v += dpp_f<0x4E>(v); v += dpp_f<0x141>(v); v += dpp_f<0x140>(v); return v; }

__device__ __forceinline__ void attn_prompt_item(const bf16* __restrict__ PROJ, bf16* __restrict__ OP, f32x2* __restrict__ ML, int item, LAS unsigned char* vst, int lane) {
    const int qb = item & 63, bhp = item >> 6, p = bhp % 3, bh = bhp / 3, h = bh & 7, b = bh >> 3;
    const int dsh = 2 * p, d = 1 << dsh, nbr = 64 >> dsh;
    const int r = qb >> (6 - dsh), jb = qb & (nbr - 1);
    const int q32 = lane & 31, h2 = lane >> 5;
    const int tbase = b * 2048 + r;
    const int mrow = tbase + d * (32 * jb + q32);
    bf16x8 qf[4];
    { const bf16* Qp = PROJ + (size_t)mrow * NPROJ + 1024 + h * 64 + 8 * h2;
#pragma unroll
      for (int s = 0; s < 4; ++s) qf[s] = *(const bf16x8*)(Qp + 16 * s); }
    f32x16 o0, o1;
#pragma unroll
    for (int i = 0; i < 16; ++i) { o0[i] = 0.f; o1[i] = 0.f; }
    float m_run = M_INIT, l_run = 0.f;
    const LAS unsigned char* vrd = vst + (4 * h2 + ((lane & 15) >> 2)) * 128 + (16 * ((lane >> 4) & 1) + 4 * (lane & 3)) * 2;
    LAS unsigned char* vwr = vst + (lane >> 3) * 128 + (lane & 7) * 16;
    const int kb_lo = jb > 4 ? jb - 4 : 0;
    for (int kb = kb_lo; kb <= jb; ++kb) {
        bf16x8 kf[4];
        { const bf16* Kp = PROJ + (size_t)(tbase + d * (32 * kb + q32)) * NPROJ + 1536 + h * 64 + 8 * h2;
#pragma unroll
          for (int s = 0; s < 4; ++s) kf[s] = *(const bf16x8*)(Kp + 16 * s); }
        u32x4 vr[4];
#pragma unroll
        for (int i = 0; i < 4; ++i) vr[i] = *(const u32x4*)(PROJ + (size_t)(tbase + d * (32 * kb + 8 * i + (lane >> 3))) * NPROJ + 2048 + h * 64 + 8 * (lane & 7));
        f32x16 st;
#pragma unroll
        for (int i = 0; i < 16; ++i) st[i] = 0.f;
#pragma unroll
        for (int s = 0; s < 4; ++s) st = __builtin_amdgcn_mfma_f32_32x32x16_bf16(kf[s], qf[s], st, 0, 0, 0);
        const bool diag = (kb == jb), edge = (kb + 4 == jb);
        float mx = M_INIT;
#pragma unroll
        for (int i = 0; i < 16; ++i) { const int ki = crow(i, h2); const bool ok = !((diag && ki > q32) || (edge && ki < q32));
            st[i] = ok ? st[i] * C2LOG : -INFINITY; mx = fmaxf(mx, st[i]); }
        mx = fmaxf(mx, __shfl_xor(mx, 32));
        const float mn = fmaxf(m_run, mx), alpha = ex2(m_run - mn);
        m_run = mn;
        float ls = 0.f;
#pragma unroll
        for (int i = 0; i < 16; ++i) { st[i] = ex2(st[i] - mn); ls += st[i]; }
        l_run = l_run * alpha + ls;
#pragma unroll
        for (int i = 0; i < 16; ++i) { o0[i] *= alpha; o1[i] *= alpha; }
        bf16x8 pa[2];
#pragma unroll
        for (int s = 0; s < 2; ++s) { u32x4 w; w.x = cvtpk(st[8 * s], st[8 * s + 1]); w.y = cvtpk(st[8 * s + 2], st[8 * s + 3]); w.z = cvtpk(st[8 * s + 4], st[8 * s + 5]); w.w = cvtpk(st[8 * s + 6], st[8 * s + 7]); pa[s] = __builtin_bit_cast(bf16x8, w); }
#pragma unroll
        for (int i = 0; i < 4; ++i) *(LAS u32x4*)(vwr + i * 1024) = vr[i];
        asm volatile("s_waitcnt lgkmcnt(0)" ::: "memory");
        __builtin_amdgcn_wave_barrier();
#pragma unroll
        for (int s = 0; s < 2; ++s) {
#pragma unroll
            for (int mb = 0; mb < 2; ++mb) {
                const s16x4 lo = __builtin_bit_cast(s16x4, __builtin_amdgcn_ds_read_tr16_b64_v4i16((LAS v4i16_t*)(vrd + s * 2048 + mb * 64)));
                const s16x4 hi = __builtin_bit_cast(s16x4, __builtin_amdgcn_ds_read_tr16_b64_v4i16((LAS v4i16_t*)(vrd + s * 2048 + 1024 + mb * 64)));
                const bf16x8 va = (bf16x8){lo[0], lo[1], lo[2], lo[3], hi[0], hi[1], hi[2], hi[3]};
                if (mb == 0) o0 = __builtin_amdgcn_mfma_f32_32x32x16_bf16(va, pa[s], o0, 0, 0, 0);
                else         o1 = __builtin_amdgcn_mfma_f32_32x32x16_bf16(va, pa[s], o1, 0, 0, 0);
            }
        }
        asm volatile("s_waitcnt lgkmcnt(0)" ::: "memory");
        __builtin_amdgcn_wave_barrier();
    }
    const float lt = l_run + __shfl_xor(l_run, 32), inv = 1.0f / lt;
    bf16* Ob = OP + ((size_t)p * MP + mrow) * 512 + h * 64 + 4 * h2;
#pragma unroll
    for (int g = 0; g < 4; ++g) {
        unsigned long long w0 = (unsigned long long)cvtpk(o0[4 * g] * inv, o0[4 * g + 1] * inv) | ((unsigned long long)cvtpk(o0[4 * g + 2] * inv, o0[4 * g + 3] * inv) << 32);
        unsigned long long w1 = (unsigned long long)cvtpk(o1[4 * g] * inv, o1[4 * g + 1] * inv) | ((unsigned long long)cvtpk(o1[4 * g + 2] * inv, o1[4 * g + 3] * inv) << 32);
        *(unsigned long long*)(Ob + 8 * g) = w0; *(unsigned long long*)(Ob + 32 + 8 * g) = w1;
    }
    if (h2 == 0) ML[((size_t)p * MP + mrow) * 8 + h] = (f32x2){m_run, lt};
}

__device__ __forceinline__ f32x4 bf4_to_f4(const bf16* p) { const unsigned long long w = *(const unsigned long long*)p; return (f32x4){bflo((unsigned)w), bfhi((unsigned)w), bflo((unsigned)(w >> 32)), bfhi((unsigned)(w >> 32))}; }
#define SAMP_UPD(kA, kB, vA, vB, okbits) do { \
    _Pragma("unroll") for (int jq = 0; jq < NQ; ++jq) { \
        _Pragma("unroll") for (int hf = 0; hf < 2; ++hf) { \
            const f32x4 k_ = hf ? (kB) : (kA), v_ = hf ? (vB) : (vA), q_ = q[jq][hf]; \
            float s_ = red16((q_.x * k_.x + q_.y * k_.y) + (q_.z * k_.z + q_.w * k_.w)); \
            s_ = (((okbits) >> jq) & 1u) ? s_ : -INFINITY; \
            const float mn_ = fmaxf(m[jq][hf], s_), al_ = ex2(m[jq][hf] - mn_), pe_ = ex2(s_ - mn_); \
            m[jq][hf] = mn_; l[jq][hf] = l[jq][hf] * al_ + pe_; o[jq][hf] = o[jq][hf] * al_ + v_ * pe_; } } } while (0)
template <int NQ, bool DENSE> __device__ __forceinline__ void samp_run(const bf16* __restrict__ PROJ, const float* __restrict__ ck, const float* __restrict__ cv, float* SPO, f32x2* SPM,
                                                                         int n, int j0, int slot, int r0, int stride, int nlo, int nhi, int lane) {
    f32x4 q[NQ][2], o[NQ][2]; float m[NQ][2], l[NQ][2];
#pragma unroll
    for (int jq = 0; jq < NQ; ++jq) {
        const bf16* qp = PROJ + (size_t)(MP + n * 4 + j0 + jq) * NPROJ + 1024 + 4 * lane;
        q[jq][0] = bf4_to_f4(qp) * C2LOG; q[jq][1] = bf4_to_f4(qp + 256) * C2LOG;
#pragma unroll
        for (int hf = 0; hf < 2; ++hf) { o[jq][hf] = (f32x4){0.f, 0.f, 0.f, 0.f}; m[jq][hf] = M_INIT; l[jq][hf] = 0.f; }
    }
#pragma unroll 2
    for (int i = 0; i < 64; ++i) {
        const int row = r0 + stride * i; const size_t off = (size_t)row * 512;
        const f32x4 kA = *(const f32x4*)(ck + off), kB = *(const f32x4*)(ck + off + 256), vA = *(const f32x4*)(cv + off), vB = *(const f32x4*)(cv + off + 256);
        unsigned okb = 0xFu;
        if (DENSE) okb = 1u | (row >= 1921 ? 2u : 0u) | (row >= 1922 ? 4u : 0u) | (row >= 1923 ? 8u : 0u);
        SAMP_UPD(kA, kB, vA, vB, okb);
    }
    for (int rn = nlo; rn < nhi; ++rn) {
        const bf16* rp = PROJ + (size_t)(MP + n * 4 + rn) * NPROJ + 4 * lane;
        const f32x4 kA = bf4_to_f4(rp + 1536), kB = bf4_to_f4(rp + 1536 + 256), vA = bf4_to_f4(rp + 2048), vB = bf4_to_f4(rp + 2048 + 256);
        unsigned okb = 0xFu;
        if (DENSE) okb = (rn <= 0 ? 1u : 0u) | (rn <= 1 ? 2u : 0u) | (rn <= 2 ? 4u : 0u) | 8u;
        SAMP_UPD(kA, kB, vA, vB, okb);
    }
#pragma unroll
    for (int jq = 0; jq < NQ; ++jq) {
        const size_t rec = ((size_t)(n * 4 + j0 + jq) * 6 + slot);
#pragma unroll
        for (int hf = 0; hf < 2; ++hf) {
            *(f32x4*)(SPO + rec * 512 + hf * 256 + 4 * lane) = o[jq][hf];
            if ((lane & 15) == 0) { f32x2 t; t.x = m[jq][hf]; t.y = l[jq][hf]; SPM[rec * 8 + hf * 4 + (lane >> 4)] = t; }
        }
    }
}
__device__ __forceinline__ void attn_sample_item(const bf16* __restrict__ PROJ, const float* __restrict__ CK, const float* __restrict__ CV, float* SPO, f32x2* SPM, int si, int lane) {
    const int n = si / 18, k = si % 18;
    const float* ck = CK + (size_t)n * 2048 * 512 + 4 * lane; const float* cv = CV + (size_t)n * 2048 * 512 + 4 * lane;
    if (k < 2) {
        samp_run<4, true>(PROJ, ck, cv, SPO, SPM, n, 0, k, 1920 + 64 * k, 1, 0, k ? 4 : 0, lane);
    } else {
        const int kk = k - 2, pat = kk >> 3, j = (kk & 7) >> 1, hf2 = kk & 1;
        const int stride = pat ? 16 : 4, r0 = (pat ? j : 1536 + j) + stride * 64 * hf2;
        samp_run<1, false>(PROJ, ck, cv, SPO, SPM, n, j, 2 + 2 * pat + hf2, r0, stride, j, hf2 ? j + 1 : j, lane);
    }
}
__device__ __forceinline__ void attn_combine_row(const bf16* __restrict__ PROJ, const bf16* __restrict__ OP, const f32x2* __restrict__ ML, const float* __restrict__ SPO, const f32x2* __restrict__ SPM,
                                                 const float* __restrict__ ga, bf16* __restrict__ Y2, int m, int lane) {
    const int hd = lane >> 3;
    float acc[8];
    if (m < MP) {
        f32x2 ml[3]; float bm = M_INIT;
#pragma unroll
        for (int p = 0; p < 3; ++p) { ml[p] = ML[((size_t)p * MP + m) * 8 + hd]; bm = fmaxf(bm, ml[p].x); }
        float w[3], den = 0.f;
#pragma unroll
        for (int p = 0; p < 3; ++p) { w[p] = ex2(ml[p].x - bm) * ml[p].y; den += w[p]; }
        const float inv = 1.0f / den;
#pragma unroll
        for (int i = 0; i < 8; ++i) acc[i] = 0.f;
#pragma unroll
        for (int p = 0; p < 3; ++p) { const u32x4 v = *(const u32x4*)(OP + ((size_t)p * MP + m) * 512 + 8 * lane); const float ww = w[p] * inv;
            acc[0] += ww * bflo(v.x); acc[1] += ww * bfhi(v.x); acc[2] += ww * bflo(v.y); acc[3] += ww * bfhi(v.y); acc[4] += ww * bflo(v.z); acc[5] += ww * bfhi(v.z); acc[6] += ww * bflo(v.w); acc[7] += ww * bfhi(v.w); }
    } else {
        const size_t rec0 = (size_t)(m - MP) * 6;
        f32x2 ml[6]; float bm = M_INIT;
#pragma unroll
        for (int s = 0; s < 6; ++s) { ml[s] = SPM[(rec0 + s) * 8 + hd]; bm = fmaxf(bm, ml[s].x); }
        float w[6], den = 0.f;
#pragma unroll
        for (int s = 0; s < 6; ++s) { w[s] = ex2(ml[s].x - bm); den += w[s] * ml[s].y; }
        const float inv = 1.0f / den;
#pragma unroll
        for (int i = 0; i < 8; ++i) acc[i] = 0.f;
#pragma unroll
        for (int s = 0; s < 6; ++s) { const f32x4 a = *(const f32x4*)(SPO + (rec0 + s) * 512 + 8 * lane), b = *(const f32x4*)(SPO + (rec0 + s) * 512 + 8 * lane + 4); const float ww = w[s] * inv;
            acc[0] += ww * a.x; acc[1] += ww * a.y; acc[2] += ww * a.z; acc[3] += ww * a.w; acc[4] += ww * b.x; acc[5] += ww * b.y; acc[6] += ww * b.z; acc[7] += ww * b.w; }
    }
    const u32x4 zw = *(const u32x4*)(PROJ + (size_t)m * NPROJ + 2560 + 8 * lane);
    const float z[8] = {bflo(zw.x), bfhi(zw.x), bflo(zw.y), bfhi(zw.y), bflo(zw.z), bfhi(zw.z), bflo(zw.w), bfhi(zw.w)};
    float ss = 0.f;
#pragma unroll
    for (int i = 0; i < 8; ++i) { acc[i] *= silu_(z[i]); ss += acc[i] * acc[i]; }
    const float rs = 1.0f / sqrtf(wave_sum(ss) * (1.f / 512) + RMS_EPS);
    const f32x4 g0 = *(const f32x4*)(ga + 8 * lane), g1 = *(const f32x4*)(ga + 8 * lane + 4);
    u32x4 o; o.x = pk2(acc[0] * rs * g0.x, acc[1] * rs * g0.y); o.y = pk2(acc[2] * rs * g0.z, acc[3] * rs * g0.w); o.z = pk2(acc[4] * rs * g1.x, acc[5] * rs * g1.y); o.w = pk2(acc[6] * rs * g1.z, acc[7] * rs * g1.w);
    *(u32x4*)(Y2 + (size_t)m * DM + 512 + 8 * lane) = o;
}

__device__ __forceinline__ void branch_norm(const float* src, const float* gg, bf16* Y2, int coff, int gw, int NGW, int lane) {
    for (int m = gw; m < MT; m += NGW) {
        const f32x4 a = *((const f32x4*)(src + (size_t)m * 512) + lane), b = *((const f32x4*)(src + (size_t)m * 512) + 64 + lane);
        const float s = (a.x * a.x + a.y * a.y) + (a.z * a.z + a.w * a.w) + (b.x * b.x + b.y * b.y) + (b.z * b.z + b.w * b.w);
        const float rs = 1.0f / sqrtf(wave_sum(s) * (1.f / 512) + RMS_EPS);
        const f32x4 g0 = *((const f32x4*)gg + lane), g1 = *((const f32x4*)gg + 64 + lane);
        unsigned long long* o8 = (unsigned long long*)(Y2 + (size_t)m * DM + coff);
        o8[lane] = (unsigned long long)pk2(a.x * rs * g0.x, a.y * rs * g0.y) | ((unsigned long long)pk2(a.z * rs * g0.z, a.w * rs * g0.w) << 32);
        o8[64 + lane] = (unsigned long long)pk2(b.x * rs * g1.x, b.y * rs * g1.y) | ((unsigned long long)pk2(b.z * rs * g1.z, b.w * rs * g1.w) << 32);
    }
}

__global__ void __launch_bounds__(NTHR, 2) fwd(Args args) {
    extern __shared__ __attribute__((aligned(16))) unsigned char lds[];
    LAS unsigned char* L = (LAS unsigned char*)lds;
    const int tid = threadIdx.x, lane = tid & 63, wave = __builtin_amdgcn_readfirstlane(tid >> 6);
    const int G = gridDim.x, gw = blockIdx.x * NWAVES + wave, NGW = G * NWAVES, gt = blockIdx.x * NTHR + tid, NGT = G * NTHR;
    unsigned char* ws = args.ws; float* out = args.out;
    bf16* Win_t = (bf16*)(ws + WS_WIN); bf16* Wglu_t = (bf16*)(ws + WS_WGLU); bf16* Wout_t = (bf16*)(ws + WS_WOUT);
    bf16* XN = (bf16*)(ws + WS_XN); bf16* PROJ = (bf16*)(ws + WS_PROJ); bf16* GB = (bf16*)(ws + WS_G); bf16* Y2 = (bf16*)(ws + WS_Y2);
    bf16* OP = (bf16*)(ws + WS_OP); f32x2* ML = (f32x2*)(ws + WS_ML); float* SPO = (float*)(ws + WS_SPO); f32x2* SPM = (f32x2*)(ws + WS_SPM);
    float* YAR = (float*)(ws + WS_YAR); float* YSR = (float*)(ws + WS_YSR); f32x2* XST = (f32x2*)(ws + WS_XST);
    const int lo = args.ph_lo, hi = args.ph_hi;
#define IN(k) (lo <= (k) && (k) < hi)
#define SEAM(k) do { if (IN(k) && IN((k) + 1)) xcd_barrier(bar); } while (0)
    gu32* ctl = (gu32*)(ws + WS_CTL);
    for (int u = tid; u < (LDS_BYTES - LDSCTL_OFF) / 4; u += NTHR) ((LAS unsigned*)(L + LDSCTL_OFF))[u] = 0u;
    __syncthreads();
    XcdBarrier bar; bar.bar = (unsigned*)(ctl + CW_BAR); bar.x = 0; bar.st = nullptr;
    if (hi - lo > 1) bar = xcd_barrier_post((unsigned*)(ctl + CW_BAR), (volatile LAS unsigned*)(L + MISC_OFF) + 8);

    if (IN(0)) {
        LAS float* scr = (LAS float*)(L + RING_OFF + wave * 16384);
        constexpr int I_A = 16 * 96, I_B = 8 * 32, I_C = 16 * 32;
        for (int it = gw; it < I_A + I_B + I_C; it += NGW) {
            int r = it;
            if (r < I_A) { const int kb = r / 96, nb = r % 96; p0_transpose_item(args.in[I_WIN], 1024, 3072, Win_t, scr, 64 * kb, 32 * nb, 32 * nb, lane); continue; } r -= I_A;
            if (r < I_B) { const int kb = r / 32, nb = r % 32; p0_transpose_item(args.in[I_WGLU], 512, 1024, Wglu_t, scr, 64 * kb, 32 * nb, glu_perm(32 * nb), lane); continue; } r -= I_B;
            { const int kb = r / 32, nb = r % 32; p0_transpose_item(args.in[I_WOUT], 1024, 1024, Wout_t, scr, 64 * kb, 32 * nb, 32 * nb, lane); }
        }
        const float* gin = args.in[I_GIN];
        for (int m = gw; m < MT; m += NGW) {
            const float* xrow = (m < MP) ? args.in[I_XP] + (size_t)m * DM : args.in[I_XS] + (size_t)(m - MP) * DM;
            const GAS f32x4* xr = (const GAS f32x4*)xrow + lane;
            f32x4 v[4]; float s = 0.f;
#pragma unroll
            for (int j = 0; j < 4; ++j) { v[j] = xr[64 * j]; s += (v[j].x * v[j].x + v[j].y * v[j].y) + (v[j].z * v[j].z + v[j].w * v[j].w); }
            const float rs = 1.0f / sqrtf(wave_sum(s) * (1.f / DM) + RMS_EPS);
            GAS unsigned long long* o8 = (GAS unsigned long long*)(XN + (size_t)m * DM) + lane;
#pragma unroll
            for (int j = 0; j < 4; ++j) { const f32x4 g4 = *((const f32x4*)gin + lane + 64 * j);
                o8[64 * j] = (unsigned long long)pk2(v[j].x * rs * g4.x, v[j].y * rs * g4.y) | ((unsigned long long)pk2(v[j].z * rs * g4.z, v[j].w * rs * g4.w) << 32); }
        }
    }
    SEAM(0);
    if (IN(1)) {
        pg8::Gemm g{XN, Win_t, MT, NPROJ, DM}; pg8::StaticOrder S; S.init(MT, NPROJ, G, (int)blockIdx.x);
        pg8::EpiProj E{PROJ, out};
        pg8::gemm_phase<pg8::EpiProj, pg8::StaticOrder, true, true>(L + RING_OFF, g, S, E);
    }
    SEAM(1);
    if (IN(2)) {
        for (int id = gt; id < 136 * 2048; id += NGT) {
            const int p = id & 63, g = (id >> 6) & 31, seq = id >> 11;
            const float dt = expf(args.in[I_LDT][g]), are = args.in[I_ARE][g * 64 + p], aim = args.in[I_AIM][g * 64 + p];
            const float mag = expf(are * dt); float sn, cs; sincos_(aim * dt, sn, cs);
            const float lr = mag * cs, li = mag * sn, den = are * are + aim * aim;
            const float fre = ((lr - 1.0f) * are + li * aim) / den, fim = (li * are - (lr - 1.0f) * aim) / den;
            float bre[16], bim[16];
#pragma unroll
            for (int c = 0; c < 16; ++c) { const float br = args.in[I_BRE][(g * 64 + p) * 16 + c], bi = args.in[I_BIM][(g * 64 + p) * 16 + c]; bre[c] = fre * br - fim * bi; bim[c] = fre * bi + fim * br; }
            int T, rowbase; float xr, xi;
            if (seq < 8) { T = 2048; rowbase = seq * 2048; xr = 0.f; xi = 0.f; }
            else { T = 4; rowbase = MP + (seq - 8) * 4; xr = args.in[I_SRE][((seq - 8) * 32 + g) * 64 + p]; xi = args.in[I_SIM][((seq - 8) * 32 + g) * 64 + p]; }
            for (int t = 0; t < T; ++t) {
                const v4u* up = (const v4u*)(PROJ + (size_t)(rowbase + t) * NPROJ + g * 16);
                const v4u u0 = up[0], u1 = up[1];
                const float u[16] = {bflo(u0.x), bfhi(u0.x), bflo(u0.y), bfhi(u0.y), bflo(u0.z), bfhi(u0.z), bflo(u0.w), bfhi(u0.w),
                                     bflo(u1.x), bfhi(u1.x), bflo(u1.y), bfhi(u1.y), bflo(u1.z), bfhi(u1.z), bflo(u1.w), bfhi(u1.w)};
                float bur = 0.f, bui = 0.f;
#pragma unroll
                for (int c = 0; c < 16; ++c) { bur = fmaf(bre[c], u[c], bur); bui = fmaf(bim[c], u[c], bui); }
                const float nr = lr * xr - li * xi + bur, ni = lr * xi + li * xr + bui; xr = nr; xi = ni;
                XST[(size_t)(rowbase + t) * 2048 + g * 64 + p] = (f32x2){xr, xi};
            }
            if (seq < 8) { out[O_RP + (seq * 32 + g) * 64 + p] = xr; out[O_IP + (seq * 32 + g) * 64 + p] = xi; }
            else { out[O_RS + ((seq - 8) * 32 + g) * 64 + p] = xr; out[O_IS + ((seq - 8) * 32 + g) * 64 + p] = xi; }
        }
    }
    SEAM(2);
    if (IN(3)) {
        for (int id = gt; id < MT * 512; id += NGT) {
            const int ch = id & 511, m = id >> 9, g = ch >> 4, c = ch & 15;
            const f32x2* xs = XST + (size_t)m * 2048 + g * 64;
            const float* cre = args.in[I_CRE] + (g * 16 + c) * 64; const float* cim = args.in[I_CIM] + (g * 16 + c) * 64;
            float y = 0.f;
            for (int p = 0; p < 64; ++p) { const f32x2 x = xs[p]; y += cre[p] * x.x - cim[p] * x.y; }
            y += args.in[I_D][ch] * bf2f(PROJ[(size_t)m * NPROJ + ch]);
            GB[(size_t)m * 512 + ch] = (bf16)f2bf(gelu_tanh(y));
        }
    }
    SEAM(3);
    if (IN(4)) {
        LAS unsigned char* vst = L + RING_OFF + wave * 4096;
        for (int si = gw; si < 128 * 18; si += NGW) attn_sample_item(PROJ, args.in[I_CK], args.in[I_CV], SPO, SPM, si, lane);
        for (int U = blockIdx.x; U < 1536; U += G) attn_prompt_item(PROJ, OP, ML, U * 8 + wave, vst, lane);
    }
    SEAM(4);
    if (IN(5)) { for (int m = gw; m < MT; m += NGW) attn_combine_row(PROJ, OP, ML, SPO, SPM, args.in[I_GA], Y2, m, lane); }
    SEAM(5);
    if (IN(6)) {
        pg8::Gemm g{GB, Wglu_t, MT, 1024, 512}; pg8::StaticOrder S; S.init(MT, 1024, G, (int)blockIdx.x);
        pg8::EpiGlu E{PROJ, args.in[I_BGLU], YSR};
        pg8::gemm_phase<pg8::EpiGlu, pg8::StaticOrder, true, true>(L + RING_OFF, g, S, E);
    }
    SEAM(6);
    if (IN(7)) branch_norm(YSR, args.in[I_GS], Y2, 0, gw, NGW, lane);
    SEAM(7);
    if (IN(8)) {
        pg8::Gemm g{Y2, Wout_t, MT, DM, DM}; pg8::StaticOrder S; S.init(MT, DM, G, (int)blockIdx.x);
        pg8::EpiOut E{args.in[I_XP], args.in[I_XS], out};
        pg8::gemm_phase<pg8::EpiOut, pg8::StaticOrder, true, true>(L + RING_OFF, g, S, E);
    }
    SEAM(8);
    if (IN(9)) {
        const float* gf = args.in[I_GF];
        for (int m = gw; m < MT; m += NGW) {
            GAS f32x4* yr = (GAS f32x4*)(out + O_YP + (size_t)m * DM) + lane;
            f32x4 v[4]; float s = 0.f;
#pragma unroll
            for (int j = 0; j < 4; ++j) { v[j] = yr[64 * j]; s += (v[j].x * v[j].x + v[j].y * v[j].y) + (v[j].z * v[j].z + v[j].w * v[j].w); }
            const float rs = 1.0f / sqrtf(wave_sum(s) * (1.f / DM) + RMS_EPS);
#pragma unroll
            for (int j = 0; j < 4; ++j) { const f32x4 g4 = *((const f32x4*)gf + lane + 64 * j); yr[64 * j] = v[j] * rs * g4; }
        }
    }
#undef IN
#undef SEAM
}

extern "C" void kernel_launch(void* const* d_in, const int* in_sizes, int n_in, void* d_out, int out_size, void* d_ws, size_t ws_size, hipStream_t stream) {
    static int grid = 0;
    if (grid == 0) {
        if (n_in != 22 || out_size != (int)O_END || ws_size < WS_END) { fprintf(stderr, "kernel_launch: unexpected shapes n_in %d out %d ws %zu\n", n_in, out_size, ws_size); grid = -1; return; }
        int dev = 0, cus = 0, per_cu = 0;
        if (hipGetDevice(&dev) != hipSuccess || hipDeviceGetAttribute(&cus, hipDeviceAttributeMultiprocessorCount, dev) != hipSuccess) { grid = -1; return; }
        if (hipFuncSetAttribute((const void*)fwd, hipFuncAttributeMaxDynamicSharedMemorySize, LDS_BYTES) != hipSuccess) { fprintf(stderr, "kernel_launch: hipFuncSetAttribute failed\n"); grid = -1; return; }
        if (hipOccupancyMaxActiveBlocksPerMultiprocessor(&per_cu, (const void*)fwd, NTHR, LDS_BYTES) != hipSuccess || per_cu < 1) fprintf(stderr, "kernel_launch: occupancy query says %d\n", per_cu);
        (void)hipGetLastError();
        grid = cus;
    }
    if (grid < 0) return;
    (void)hipMemsetAsync((char*)d_ws + WS_CTL, 0, CTL_ZERO_BYTES, stream);
    Args a{};
    for (int i = 0; i < 22; ++i) a.in[i] = (const float*)d_in[i];
    a.out = (float*)d_out; a.ws = (unsigned char*)d_ws;
#if defined(MK_PER_PHASE)
    for (int ph = 0; ph < NPHASE; ++ph) { a.ph_lo = ph; a.ph_hi = ph + 1; hipLaunchKernelGGL(fwd, dim3(grid), dim3(NTHR), LDS_BYTES, stream, a); }
#else
    a.ph_lo = 0; a.ph_hi = NPHASE;
    hipLaunchKernelGGL(fwd, dim3(grid), dim3(NTHR), LDS_BYTES, stream, a);
#endif
}
```

```cpp
#include <hip/hip_runtime.h>
#include <cstdio>
#include <cstdint>
constexpr size_t O_YP = 0, O_YS = 16777216, O_KP = 17301504, O_VP = 25690112, O_RP = 34078720, O_IP = 34095104,
                 O_KS = 34111488, O_VS = 34373632, O_RS = 34635776, O_IS = 34897920, O_END = 35160064;
constexpr int MP = 16384, MS = 512, MT = MP + MS;
constexpr int DM = 1024, NPROJ = 3072;
__device__ __forceinline__ int lane_id() { int l; asm volatile("v_mbcnt_lo_u32_b32 %0, -1, 0\n\tv_mbcnt_hi_u32_b32 %0, -1, %0" : "=v"(l)); return l; }
namespace pg8 {
#define PG8_LAS __attribute__((address_space(3)))
typedef unsigned short bf16_t;
typedef short bf16x8 __attribute__((ext_vector_type(8)));
typedef float f32x4 __attribute__((ext_vector_type(4)));
typedef unsigned u32x4 __attribute__((ext_vector_type(4)));
constexpr int BM = 256, BK = 64, HALF = 128, HTB = HALF * BK * 2  , STAGE_BYTES = 8 * HTB, NXCD = 8, WGM = 8;

__host__ __device__ __forceinline__ int lds_byte(int r, int c) { const int st = (r >> 4) * 2 + (c >> 5), rr = r & 15, cc = c & 31, ob = rr * 64 + cc * 2; return st * 1024 + (ob ^ (((ob >> 9) & 1) << 5)); }
__host__ __device__ __forceinline__ void stage_rc(int b, int& R, int& C) { const int st = b / 1024, sb = b % 1024, swz = sb ^ (((sb >> 9) & 1) << 5); R = (st >> 1) * 16 + swz / 64; C = (st & 1) * 32 + (swz % 64) / 2; }
__host__ __device__ __forceinline__ int perm32(int rho) { const int n = rho >> 4, i = rho & 15; return 8 * (i >> 2) + 4 * n + (i & 3); }

struct Unit { int pm, pn; };
struct Gemm { const bf16_t* A; const bf16_t* Bt; int M, N, K, lda, ldb; };

struct StaticOrder {
    int nM, nN, nwg, G, c;
    __host__ __device__ void init(int M, int N, int G_, int c_) { nM = M / BM; nN = N / BM; nwg = nM * nN; G = G_; c = c_; }
    __host__ __device__ bool next(int i, Unit& u) const {
        const long L = (long)i * G + c; if (L >= nwg) return false;
        int wgid = (int)L; { const int q = nwg / NXCD, r = nwg % NXCD, xcd = wgid % NXCD, off = wgid / NXCD; wgid = (xcd < r ? xcd * (q + 1) : r * (q + 1) + (xcd - r) * q) + off; }
        const int nig = WGM * nN, gid = wgid / nig, fm = gid * WGM, gsz = (nM - fm) < WGM ? (nM - fm) : WGM;
        u.pm = fm + ((wgid % nig) % gsz); u.pn = (wgid % nig) / gsz; return true;
    }
    __device__ __forceinline__ void a_ready(const Unit&) const {}
    __device__ __forceinline__ void done(const Unit&) const {}
};

__device__ __forceinline__ unsigned cvt_pk_bf16(float lo, float hi) { unsigned r; asm volatile("v_cvt_pk_bf16_f32 %0, %1, %2" : "=v"(r) : "v"(lo), "v"(hi)); return r; }
typedef float f32x2 __attribute__((ext_vector_type(2)));
typedef unsigned u32x4 __attribute__((ext_vector_type(4)));
__device__ __forceinline__ float bf2f(unsigned short u) { return __uint_as_float(((unsigned)u) << 16); }
__device__ __forceinline__ float bflo(unsigned w) { return __uint_as_float(w << 16); }
__device__ __forceinline__ float bfhi(unsigned w) { return __uint_as_float(w & 0xffff0000u); }
__device__ __forceinline__ float sigmoidf_(float x) { return 1.0f / (1.0f + __expf(-x)); }
struct EpiProj {
    static constexpr bool PERM = true, AFTER_DRAIN = false;
    bf16_t* P; float* out; bf16_t* UA;
    __device__ __forceinline__ void operator()(const f32x4 (&acc)[2][2][4][2], const Unit& u, int wr, int wc, int fr, int fq) const {
        const int row0 = u.pm * BM + wr * 64 + fr, col0 = u.pn * BM + wc * 32 + 8 * fq;
        if (u.pn < 2 && u.pm < 64) {
#pragma unroll
            for (int ai = 0; ai < 2; ++ai)
#pragma unroll
                for (int m = 0; m < 4; ++m) {
                    const int row = row0 + ai * HALF + m * 16, ch = ((row >> 11) << 7) + ((row & 2047) >> 4), tk = row & 15;
#pragma unroll
                    for (int bj = 0; bj < 2; ++bj) {
                        const int col = col0 + bj * HALF, g = col >> 4, c0 = col & 15;
                        const f32x4 v0 = acc[ai][bj][m][0], v1 = acc[ai][bj][m][1];
                        u32x4 w; w.x = cvt_pk_bf16(v0[0], v0[1]); w.y = cvt_pk_bf16(v0[2], v0[3]); w.z = cvt_pk_bf16(v1[0], v1[1]); w.w = cvt_pk_bf16(v1[2], v1[3]);
                        *(u32x4*)(UA + ((size_t)(g * 1024 + ch)) * 384 + tk * 16 + c0) = w;
                    }
                }
            return;
        }
        float* fo = nullptr;
        if (u.pn >= 6 && u.pn < 10) {
            const bool isv = u.pn >= 8; const int cb = isv ? 2048 : 1536;
            if (u.pm < 64) fo = out + (isv ? O_VP : O_KP) + (size_t)row0 * 512 + (col0 - cb);
            else           fo = out + (isv ? O_VS : O_KS) + (size_t)(row0 - MP) * 512 + (col0 - cb);
        }
#pragma unroll
        for (int ai = 0; ai < 2; ++ai)
#pragma unroll
            for (int m = 0; m < 4; ++m) {
                const int rr = ai * HALF + m * 16;
                bf16_t* rowp = P + (size_t)(row0 + rr) * NPROJ + col0;
#pragma unroll
                for (int bj = 0; bj < 2; ++bj) {
                    const f32x4 v0 = acc[ai][bj][m][0], v1 = acc[ai][bj][m][1];
                    u32x4 w; w.x = cvt_pk_bf16(v0[0], v0[1]); w.y = cvt_pk_bf16(v0[2], v0[3]); w.z = cvt_pk_bf16(v1[0], v1[1]); w.w = cvt_pk_bf16(v1[2], v1[3]);
                    *(u32x4*)(rowp + bj * HALF) = w;
                    if (fo) { float* f = fo + (size_t)rr * 512 + bj * HALF; *(f32x4*)f = v0; *(f32x4*)(f + 4) = v1; }
                }
            }
    }
};
struct SsmOrder {
    int G, c;
    __device__ __forceinline__ bool next(int i, Unit& u) const { const int L = i * G + c; if (L >= 128) return false; u.pm = L; u.pn = L >> 2; return true; }
    __device__ __forceinline__ void a_ready(const Unit&) const {}
    __device__ __forceinline__ void done(const Unit&) const {}
};
struct EpiSsmS {
    static constexpr bool PERM = false, AFTER_DRAIN = false;
    float* SL;
    __device__ __forceinline__ void operator()(const f32x4 (&acc)[2][2][4][2], const Unit& u, int wr, int wc, int fr, int fq) const {
        const int row0 = u.pm * BM + wr * 64 + fr, col0 = wc * 32 + 4 * fq;
#pragma unroll
        for (int ai = 0; ai < 2; ++ai)
#pragma unroll
            for (int m = 0; m < 4; ++m)
#pragma unroll
                for (int n = 0; n < 2; ++n) *(f32x4*)(SL + (size_t)(row0 + ai * HALF + m * 16) * 128 + col0 + n * 16) = acc[ai][0][m][n];
    }
};
__device__ __forceinline__ float gelu_t(float x) { const float z = 0.7978845608028654f * (x + 0.044715f * x * x * x); const float t = __expf(2.0f * z); return 0.5f * x * (2.0f - 2.0f / (t + 1.0f)); }
struct EpiSsmY {
    static constexpr bool PERM = true, AFTER_DRAIN = false;
    bf16_t* GB;
    __device__ __forceinline__ void operator()(const f32x4 (&acc)[2][2][4][2], const Unit& u, int wr, int wc, int fr, int fq) const {
        const int g = u.pn, chl0 = (u.pm & 3) * BM + wr * 64 + fr;
#pragma unroll
        for (int ai = 0; ai < 2; ++ai)
#pragma unroll
            for (int m = 0; m < 4; ++m) {
                const int ch = chl0 + ai * HALF + m * 16, b = ch >> 7, tk = (ch & 127) * 16;
#pragma unroll
                for (int bj = 0; bj < 2; ++bj) {
                    const int col0 = bj * HALF + wc * 32 + 8 * fq, i = col0 >> 4, c0 = col0 & 15;
                    const f32x4 v0 = acc[ai][bj][m][0], v1 = acc[ai][bj][m][1];
                    u32x4 w; w.x = cvt_pk_bf16(gelu_t(v0[0]), gelu_t(v0[1])); w.y = cvt_pk_bf16(gelu_t(v0[2]), gelu_t(v0[3])); w.z = cvt_pk_bf16(gelu_t(v1[0]), gelu_t(v1[1])); w.w = cvt_pk_bf16(gelu_t(v1[2]), gelu_t(v1[3]));
                    *(u32x4*)(GB + (size_t)(b * 2048 + tk + i) * 512 + g * 16 + c0) = w;
                }
                __builtin_amdgcn_sched_barrier(0);
            }
    }
};
struct EpiGlu {
    static constexpr bool PERM = true, AFTER_DRAIN = false;
    const bf16_t* P; const float* bglu; float* YSR;
    __device__ __forceinline__ void operator()(const f32x4 (&acc)[2][2][4][2], const Unit& u, int wr, int wc, int fr, int fq) const {
        const int row0 = u.pm * BM + wr * 64 + fr, cv0 = u.pn * HALF + wc * 32 + 8 * fq;
        const f32x4 bv0 = *(const f32x4*)(bglu + cv0), bv1 = *(const f32x4*)(bglu + cv0 + 4), bg0 = *(const f32x4*)(bglu + 512 + cv0), bg1 = *(const f32x4*)(bglu + 512 + cv0 + 4);
#pragma unroll
        for (int ai = 0; ai < 2; ++ai)
#pragma unroll
            for (int m = 0; m < 4; ++m) {
                const int row = row0 + ai * HALF + m * 16;
                const u32x4 zw = *(const u32x4*)(P + (size_t)row * NPROJ + 512 + cv0);
                const float z[8] = {bflo(zw.x), bfhi(zw.x), bflo(zw.y), bfhi(zw.y), bflo(zw.z), bfhi(zw.z), bflo(zw.w), bfhi(zw.w)};
                f32x4 o0, o1;
#pragma unroll
                for (int i = 0; i < 4; ++i) {
                    const float va = acc[ai][0][m][0][i] + bv0[i], ga = acc[ai][1][m][0][i] + bg0[i];
                    const float vb = acc[ai][0][m][1][i] + bv1[i], gb = acc[ai][1][m][1][i] + bg1[i];
                    o0[i] = va * sigmoidf_(ga) * (z[i] * sigmoidf_(z[i]));
                    o1[i] = vb * sigmoidf_(gb) * (z[4 + i] * sigmoidf_(z[4 + i]));
                }
                float* yp = YSR + (size_t)row * 512 + cv0; *(f32x4*)yp = o0; *(f32x4*)(yp + 4) = o1;
            }
    }
};
struct EpiOut {
    static constexpr bool PERM = false, AFTER_DRAIN = false;
    const float* xp; const float* xs; float* out;
    __device__ __forceinline__ void operator()(const f32x4 (&acc)[2][2][4][2], const Unit& u, int wr, int wc, int fr, int fq) const {
        const int row0 = u.pm * BM + wr * 64 + fr, col0 = u.pn * BM + wc * 32 + 4 * fq;
        const float* xb = (u.pm < 64) ? xp + (size_t)row0 * DM : xs + (size_t)(row0 - MP) * DM;
        float* ob = out + O_YP + (size_t)row0 * DM;
#pragma unroll
        for (int ai = 0; ai < 2; ++ai)
#pragma unroll
            for (int m = 0; m < 4; ++m) {
                const size_t ro = (size_t)(ai * HALF + m * 16) * DM + col0;
#pragma unroll
                for (int bj = 0; bj < 2; ++bj)
#pragma unroll
                    for (int n = 0; n < 2; ++n) { const size_t o = ro + bj * HALF + n * 16; *(f32x4*)(ob + o) = *(const f32x4*)(xb + o) + acc[ai][bj][m][n]; }
            }
    }
};
template <class Epi, class Sched, bool ALIGN_EPI = false, bool SP2 = false>
__device__ __forceinline__ void gemm_phase(PG8_LAS unsigned char* lds, const Gemm g, const Sched& S, const Epi& E, const int wid) {
    const int lane = lane_id(), tid = wid * 64 + lane, wr = wid >> 2, wc = wid & 3, fr = lane & 15, fq = lane >> 4;
    const int K = g.K, nt = K / BK;
    unsigned voffA[2], voffB[2];
#pragma unroll
    for (int i = 0; i < 2; ++i) { int R, C; stage_rc(tid * 16 + i * 8192, R, C); const int Rb = Epi::PERM ? ((R & ~31) + perm32(R & 31)) : R;
        voffA[i] = (unsigned)(R * g.lda + C) * 2u; voffB[i] = (unsigned)(Rb * g.ldb + C) * 2u; }
    const size_t kstep = (size_t)(BK * 2);
    const size_t hstepA = (size_t)HALF * g.lda * 2, hstepB = (size_t)HALF * g.ldb * 2;
    const size_t tstepA = 2 * hstepA, tstepB = 2 * hstepB;
    const unsigned ldsw = (unsigned)wid * 1024u;
    const int aoff = lds_byte(wr * 64 + fr, fq * 8), boff = lds_byte(wc * 32 + fr, fq * 8);
#define PG8_SA(b, h) (((b) * 2 + (h)) * HTB)
#define PG8_SB(b, h) ((4 + (b) * 2 + (h)) * HTB)
#define PG8_STAGE(bufoff, gbase, voff) do { _Pragma("unroll") for (int _i = 0; _i < 2; ++_i) \
        __builtin_amdgcn_global_load_lds((const unsigned*)((const char*)(gbase) + (voff)[_i]), (PG8_LAS unsigned*)(lds + (bufoff) + ldsw + _i * 8192), 16, 0, 0); } while (0)
#define PG8_LDA(dst, b, h) do { _Pragma("unroll") for (int m = 0; m < 4; ++m) _Pragma("unroll") for (int k = 0; k < 2; ++k) dst[m][k] = *(const PG8_LAS bf16x8*)(lds + PG8_SA(b, h) + aoff + m * 2048 + k * 1024); } while (0)
#define PG8_LDB(dst, b, h) do { _Pragma("unroll") for (int n = 0; n < 2; ++n) _Pragma("unroll") for (int k = 0; k < 2; ++k) dst[n][k] = *(const PG8_LAS bf16x8*)(lds + PG8_SB(b, h) + boff + n * 2048 + k * 1024); } while (0)
#define PG8_MMA(ai, bj, At, Bt) do { __builtin_amdgcn_s_setprio(1); _Pragma("unroll") for (int m = 0; m < 4; ++m) _Pragma("unroll") for (int n = 0; n < 2; ++n) _Pragma("unroll") for (int k = 0; k < 2; ++k) \
        acc[ai][bj][m][n] = __builtin_amdgcn_mfma_f32_16x16x32_bf16(Bt[n][k], At[m][k], acc[ai][bj][m][n], 0, 0, 0); __builtin_amdgcn_s_setprio(0); } while (0)
#define PG8_WAIT_V(n) asm volatile("s_waitcnt vmcnt(" #n ")" ::: "memory")
#define PG8_WAIT_L(n) asm volatile("s_waitcnt lgkmcnt(" #n ")" ::: "memory")
#define PG8_BAR __builtin_amdgcn_s_barrier()
#define PG8_SCHED __builtin_amdgcn_sched_barrier(0)
    Unit cur, nxt; int ui = 0;
    if (!S.next(0, cur)) return;
    f32x4 acc[2][2][4][2];
#pragma unroll
    for (int a = 0; a < 2; ++a)
#pragma unroll
        for (int b = 0; b < 2; ++b)
#pragma unroll
            for (int m = 0; m < 4; ++m)
#pragma unroll
                for (int n = 0; n < 2; ++n) acc[a][b][m][n] = (f32x4){0.f, 0.f, 0.f, 0.f};
    bf16x8 At[4][2], B0[2][2], B1[2][2];
    const char* cA = (const char*)g.A + (size_t)cur.pm * tstepA; const char* cB = (const char*)g.Bt + (size_t)cur.pn * tstepB;
    S.a_ready(cur);
    if constexpr (SP2) {
        PG8_STAGE(PG8_SB(0, 0), cB, voffB); PG8_STAGE(PG8_SB(0, 1), cB + hstepB, voffB); PG8_STAGE(PG8_SA(0, 0), cA, voffA); PG8_STAGE(PG8_SA(0, 1), cA + hstepA, voffA);
        if (wr == 1) PG8_BAR;
        PG8_WAIT_V(2); PG8_BAR;
        PG8_STAGE(PG8_SB(1, 0), cB + kstep, voffB); PG8_STAGE(PG8_SA(1, 0), cA + kstep, voffA); PG8_STAGE(PG8_SB(1, 1), cB + hstepB + kstep, voffB);
        PG8_WAIT_V(6); PG8_BAR;
    } else {
        PG8_STAGE(PG8_SB(0, 0), cB, voffB); PG8_STAGE(PG8_SA(0, 0), cA, voffA); PG8_STAGE(PG8_SB(0, 1), cB + hstepB, voffB); PG8_STAGE(PG8_SA(0, 1), cA + hstepA, voffA);
        if (wr == 1) PG8_BAR;
        PG8_WAIT_V(4); PG8_BAR;
        PG8_STAGE(PG8_SB(1, 0), cB + kstep, voffB); PG8_STAGE(PG8_SA(1, 0), cA + kstep, voffA); PG8_STAGE(PG8_SB(1, 1), cB + hstepB + kstep, voffB);
        PG8_WAIT_V(6); PG8_BAR;
    }
    for (;;) {
        const bool has_next = S.next(ui + 1, nxt);
        const char* nA = has_next ? (const char*)g.A + (size_t)nxt.pm * tstepA : cA; const char* nB = has_next ? (const char*)g.Bt + (size_t)nxt.pn * tstepB : cB;
        for (int t = 0; t < nt; t += 2) {
            const bool last = (t == nt - 2);
            const char* a1 = cA + (size_t)(t + 1) * kstep;
            const char* a2 = last ? nA : cA + (size_t)(t + 2) * kstep; const char* b2 = last ? nB : cB + (size_t)(t + 2) * kstep;
            const char* a3 = a2 + kstep; const char* b3 = b2 + kstep;
            if (last && has_next) S.a_ready(nxt);
            if constexpr (SP2) {
            PG8_LDB(B0, 0, 0); PG8_LDB(B1, 0, 1); PG8_SCHED; PG8_LDA(At, 0, 0); PG8_STAGE(PG8_SA(1, 1), a1 + hstepA, voffA);
            PG8_WAIT_V(8); PG8_WAIT_L(0); PG8_BAR; PG8_MMA(0, 0, At, B0); PG8_MMA(0, 1, At, B1); PG8_BAR; PG8_SCHED;
            PG8_LDA(At, 0, 1); PG8_STAGE(PG8_SB(0, 0), b2, voffB); PG8_STAGE(PG8_SB(0, 1), b2 + hstepB, voffB); PG8_STAGE(PG8_SA(0, 0), a2, voffA);
            PG8_WAIT_V(8); PG8_WAIT_L(0); PG8_BAR; PG8_MMA(1, 0, At, B0); PG8_MMA(1, 1, At, B1); PG8_BAR; PG8_SCHED;
            PG8_LDB(B0, 1, 0); PG8_LDB(B1, 1, 1); PG8_SCHED; PG8_LDA(At, 1, 0); PG8_STAGE(PG8_SA(0, 1), a2 + hstepA, voffA);
            PG8_WAIT_V(8); PG8_WAIT_L(0); PG8_BAR; PG8_MMA(0, 0, At, B0); PG8_MMA(0, 1, At, B1); PG8_BAR; PG8_SCHED;
            PG8_LDA(At, 1, 1); PG8_STAGE(PG8_SB(1, 0), b3, voffB); PG8_STAGE(PG8_SB(1, 1), b3 + hstepB, voffB); PG8_STAGE(PG8_SA(1, 0), a3, voffA);
            PG8_WAIT_V(8); PG8_WAIT_L(0); PG8_BAR; PG8_MMA(1, 0, At, B0); PG8_MMA(1, 1, At, B1); PG8_BAR; PG8_SCHED;
            } else {
            PG8_LDB(B0, 0, 0); PG8_SCHED; PG8_LDA(At, 0, 0); PG8_STAGE(PG8_SA(1, 1), a1 + hstepA, voffA);
            PG8_WAIT_L(8); PG8_BAR; PG8_WAIT_L(0); PG8_MMA(0, 0, At, B0); PG8_BAR; PG8_SCHED;
            PG8_LDB(B1, 0, 1); PG8_STAGE(PG8_SB(0, 0), b2, voffB);
            PG8_BAR; PG8_WAIT_L(0); PG8_MMA(0, 1, At, B1); PG8_BAR;
            PG8_LDA(At, 0, 1); PG8_STAGE(PG8_SA(0, 0), a2, voffA);
            PG8_BAR; PG8_WAIT_L(0); PG8_MMA(1, 0, At, B0); PG8_BAR; PG8_SCHED;
            PG8_STAGE(PG8_SB(0, 1), b2 + hstepB, voffB);
            PG8_WAIT_V(6); PG8_BAR; PG8_MMA(1, 1, At, B1); PG8_BAR;
            PG8_LDB(B0, 1, 0); PG8_SCHED; PG8_LDA(At, 1, 0); PG8_STAGE(PG8_SA(0, 1), a2 + hstepA, voffA);
            PG8_WAIT_L(8); PG8_BAR; PG8_WAIT_L(0); PG8_MMA(0, 0, At, B0); PG8_BAR; PG8_SCHED;
            PG8_LDB(B1, 1, 1); PG8_STAGE(PG8_SB(1, 0), b3, voffB);
            PG8_BAR; PG8_WAIT_L(0); PG8_MMA(0, 1, At, B1); PG8_BAR;
            PG8_LDA(At, 1, 1); PG8_STAGE(PG8_SA(1, 0), a3, voffA);
            PG8_BAR; PG8_WAIT_L(0); PG8_MMA(1, 0, At, B0); PG8_BAR; PG8_SCHED;
            PG8_STAGE(PG8_SB(1, 1), b3 + hstepB, voffB);
            PG8_WAIT_V(6); PG8_BAR; PG8_MMA(1, 1, At, B1); PG8_BAR;
            }
        }
        if constexpr (ALIGN_EPI) { if (wr == 0) PG8_BAR; }
        if constexpr (!Epi::AFTER_DRAIN) { E(acc, cur, wr, wc, fr, fq); S.done(cur); }
        if (!has_next) break;
#pragma unroll
        for (int a = 0; a < 2; ++a)
#pragma unroll
            for (int b = 0; b < 2; ++b)
#pragma unroll
                for (int m = 0; m < 4; ++m)
#pragma unroll
                    for (int n = 0; n < 2; ++n) acc[a][b][m][n] = (f32x4){0.f, 0.f, 0.f, 0.f};
        cur = nxt; cA = nA; cB = nB; ++ui;
        if constexpr (ALIGN_EPI) { if (wr == 1) PG8_BAR; }
    }
    PG8_WAIT_V(0);
    if constexpr (!ALIGN_EPI) { if (wr == 0) PG8_BAR; }
    PG8_BAR;
    if constexpr (Epi::AFTER_DRAIN) { E.fused(acc, cur, wr, wc, fr, fq, lds, wid, lane); S.done(cur); }
#undef PG8_SA
#undef PG8_SB
#undef PG8_STAGE
#undef PG8_LDA
#undef PG8_LDB
#undef PG8_MMA
#undef PG8_WAIT_V
#undef PG8_WAIT_L
#undef PG8_BAR
#undef PG8_SCHED
}
}
#define PG8_UNUSED 0
#define GAS __attribute__((address_space(1)))
#define LAS __attribute__((address_space(3)))
typedef unsigned short bf16;
typedef unsigned v4u __attribute__((ext_vector_type(4)));
typedef float f32x4 __attribute__((ext_vector_type(4)));
typedef short bf16x8 __attribute__((ext_vector_type(8)));
typedef GAS unsigned gu32;
typedef GAS unsigned long long gu64;
#define RLX_AGENT __ATOMIC_RELAXED, __HIP_MEMORY_SCOPE_AGENT
#define LDS_WAIT() asm volatile("s_waitcnt lgkmcnt(0)" ::: "memory")
#define VM_WAIT() asm volatile("s_waitcnt vmcnt(0)" ::: "memory")
__device__ __forceinline__ unsigned long long rt() { return __builtin_amdgcn_s_memrealtime(); }
__device__ __forceinline__ unsigned f2bf(float f) { unsigned u = __builtin_bit_cast(unsigned, f); return (u + 0x7fffu + ((u >> 16) & 1u)) >> 16; }
__device__ __forceinline__ unsigned pk2(float lo, float hi) { return f2bf(lo) | (f2bf(hi) << 16); }

#define XB_TMO      128
#define XB_XCNT(j)  (256  + 64 * (j))
#define XB_XSUB(j)  (1280 + 64 * (j))
#define XB_XGEN(j)  (2304 + 64 * (j))
#define XB_TOP      3328
#define XB_TOPGEN   3392
#define XCD_BAR_WORDS 3456
#define XB_SPIN_CAP (1u << 18)

__device__ __forceinline__ unsigned xb_ld(unsigned* p)              { return __hip_atomic_load(p, __ATOMIC_RELAXED, __HIP_MEMORY_SCOPE_AGENT); }
__device__ __forceinline__ unsigned xb_add(unsigned* p, unsigned v) { return __hip_atomic_fetch_add(p, v, __ATOMIC_RELAXED, __HIP_MEMORY_SCOPE_AGENT); }
__device__ __forceinline__ unsigned xb_xcc_id() { return (unsigned)__builtin_amdgcn_s_getreg((3 << 11) | 20) & 0xFu; }
#define XB_SPIN(cond, bar) do { unsigned _sp = 0; while (cond) { __builtin_amdgcn_s_sleep(1); \
    if ((++_sp & 255u) == 0u) { if (xb_ld(&(bar)[XB_TMO])) break; if (_sp > XB_SPIN_CAP) { atomicAdd(&(bar)[XB_TMO], 1u); break; } } } } while (0)

struct XcdBarrier {
    unsigned* bar; unsigned x; int w;
    volatile LAS unsigned* st;
};

__device__ __forceinline__ XcdBarrier xcd_barrier_post(unsigned* bar, volatile LAS unsigned* st, int wave) {
    XcdBarrier b; b.bar = bar; b.x = xb_xcc_id(); b.st = st; b.w = wave;
    if (wave == 0 && lane_id() == 0) (void)xb_add(&bar[XB_XCNT(b.x)], 1u);
    return b;
}
__device__ __forceinline__ void xcd_barrier_complete(unsigned* bar, unsigned x, unsigned& nloc, unsigned& nx) {
    const unsigned G = gridDim.x * gridDim.y * gridDim.z;
    unsigned sum, cnt, mine, sp = 0u;
    for (;;) {
        sum = 0u; cnt = 0u; mine = 0u;
#pragma unroll
        for (unsigned j = 0; j < 16; ++j) { const unsigned c = xb_ld(&bar[XB_XCNT(j)]); sum += c; cnt += (c > 0u) ? 1u : 0u; mine = (j == x) ? c : mine; }
        if (sum == G) break;
        __builtin_amdgcn_s_sleep(1);
        if ((++sp & 255u) == 0u) { if (xb_ld(&bar[XB_TMO])) break; if (sp > XB_SPIN_CAP) { atomicAdd(&bar[XB_TMO], 1u); break; } }
    }
    nloc = mine > 0u ? mine : 1u; nx = cnt > 0u ? cnt : 1u;
}

__device__ __forceinline__ void xcd_barrier(const XcdBarrier& b) {
    asm volatile("s_waitcnt vmcnt(0)" ::: "memory");
    __syncthreads();
    if (b.w == 0 && lane_id() == 0) {
        unsigned* bar = b.bar;
        __builtin_amdgcn_s_waitcnt(0);
        unsigned nloc = b.st[0], nx = b.st[1];
        if (nloc == 0u) { xcd_barrier_complete(bar, b.x, nloc, nx); b.st[0] = nloc; b.st[1] = nx; }
        const unsigned old = xb_add(&bar[XB_XSUB(b.x)], 1u);
        const unsigned gen = old / nloc;
        if (old + 1u == (gen + 1u) * nloc) {
            __builtin_amdgcn_fence(__ATOMIC_RELEASE, "agent");
            asm volatile("s_waitcnt vmcnt(0)" ::: "memory");
            const unsigned og = xb_add(&bar[XB_TOP], 1u);
            const unsigned tg = og / nx;
            if (og + 1u == (tg + 1u) * nx) xb_add(&bar[XB_TOPGEN], 1u);
            else XB_SPIN(xb_ld(&bar[XB_TOPGEN]) == tg, bar);
            __builtin_amdgcn_fence(__ATOMIC_ACQUIRE, "agent");
            xb_add(&bar[XB_XGEN(b.x)], 1u);
            asm volatile("s_waitcnt vmcnt(0)" ::: "memory");
        } else {
            XB_SPIN(xb_ld(&bar[XB_XGEN(b.x)]) == gen, bar);
            __builtin_amdgcn_fence(__ATOMIC_ACQUIRE, "agent");
            asm volatile("s_waitcnt vmcnt(0)" ::: "memory");
        }
    }
    __syncthreads();
}
constexpr int NWAVES = 8, NTHR = 512;
constexpr size_t MiB = 1u << 20;
constexpr size_t WS_CTL = 0, CTL_ZERO_BYTES = 1 * MiB;
constexpr size_t WS_WIN = 2 * MiB, WS_WGLU = 8 * MiB, WS_WOUT = 10 * MiB;
constexpr size_t WS_XN = 16 * MiB;
constexpr size_t WS_PROJ = 64 * MiB;
constexpr size_t WS_G = 176 * MiB;
constexpr size_t WS_Y2 = 200 * MiB;
constexpr size_t WS_YAR = 240 * MiB, WS_YSR = 280 * MiB;
constexpr size_t WS_UA = 320 * MiB, WS_WSS = 344 * MiB, WS_WYS = 348 * MiB, WS_SL = 354 * MiB;
constexpr size_t WS_XST = 370 * MiB;
constexpr size_t WS_OP = 600 * MiB, WS_ML = 650 * MiB, WS_SPO = 654 * MiB, WS_SPM = 661 * MiB;
constexpr size_t WS_END = 662 * MiB;
constexpr int CW_BAR = 4096;
constexpr int RING_OFF = 0, RING_BYTES = 131072, LDSCTL_OFF = RING_BYTES, MISC_OFF = LDSCTL_OFF + 320, LDS_BYTES = 147456;
constexpr float RMS_EPS = 1e-6f;
constexpr int NPHASE = 9;

typedef float f32x2 __attribute__((ext_vector_type(2)));
typedef unsigned u32x4 __attribute__((ext_vector_type(4)));
__device__ __forceinline__ float bf2f(unsigned short u) { return __uint_as_float(((unsigned)u) << 16); }
__device__ __forceinline__ float bflo(unsigned w) { return __uint_as_float(w << 16); }
__device__ __forceinline__ float bfhi(unsigned w) { return __uint_as_float(w & 0xffff0000u); }
__device__ __forceinline__ float wave_sum(float v) {
#pragma unroll
    for (int o = 1; o < 64; o <<= 1) v += __shfl_xor(v, o);
    return v;
}
__device__ __forceinline__ void sincos_(float x, float& s, float& c) {
    const float k = rintf(x * 0.63661977236758134f);
    float r = fmaf(-k, 1.5703125f, x); r = fmaf(-k, 4.837512969970703125e-4f, r); r = fmaf(-k, 7.54978995489188216e-8f, r);
    const float z = r * r;
    const float sp = r + r * z * (-1.6666654611e-1f + z * (8.3321608736e-3f + z * (-1.9515295891e-4f)));
    const float cp = 1.0f - 0.5f * z + z * z * (4.166664568298827e-2f + z * (-1.388731625493765e-3f + z * 2.443315711809948e-5f));
    const int q = ((int)k) & 3;
    const float ss = (q & 1) ? cp : sp, cc = (q & 1) ? sp : cp;
    s = (q & 2) ? -ss : ss; c = ((q + 1) & 2) ? -cc : cc;
}
__device__ __forceinline__ float gelu_tanh(float x) {
    const float z = 0.7978845608028654f * (x + 0.044715f * x * x * x);
    const float t = __expf(2.0f * z);
    const float th = 1.0f - 2.0f / (t + 1.0f);
    return 0.5f * x * (1.0f + th);
}
__device__ __forceinline__ float silu_(float z) { return z / (1.0f + __expf(-z)); }

struct Args { const float* in[22]; float* out; unsigned char* ws; int ph_lo, ph_hi; };
enum { I_XP = 0, I_XS, I_CK, I_CV, I_SRE, I_SIM, I_GIN, I_WIN, I_ARE, I_AIM, I_LDT, I_BRE, I_BIM, I_CRE, I_CIM, I_D, I_WGLU, I_BGLU, I_GS, I_GA, I_WOUT, I_GF };

__device__ __forceinline__ void p0_transpose_item(const float* W, int K, int N, bf16* WT, LAS float* scr, int k0, int n0, int drow0, int lane) {
#pragma unroll 8
    for (int i = 0; i < 32; ++i) { const int kk = 2 * i + (lane >> 5); scr[kk * 33 + (lane & 31)] = W[(size_t)(k0 + kk) * N + n0 + (lane & 31)]; }
    LDS_WAIT(); asm volatile("" ::: "memory");
    const int c = lane & 7;
#pragma unroll
    for (int j = 0; j < 4; ++j) { const int n = (lane >> 3) + 8 * j; const LAS float* s = scr + (8 * c) * 33 + n;
        v4u o; o.x = pk2(s[0 * 33], s[1 * 33]); o.y = pk2(s[2 * 33], s[3 * 33]); o.z = pk2(s[4 * 33], s[5 * 33]); o.w = pk2(s[6 * 33], s[7 * 33]);
        *(GAS v4u*)(WT + (size_t)(drow0 + n) * K + k0 + 8 * c) = o; }
    LDS_WAIT(); asm volatile("" ::: "memory");
}
__device__ __forceinline__ int glu_perm(int n) { return n < 512 ? (n >> 7) * 256 + (n & 127) : ((n - 512) >> 7) * 256 + 128 + ((n - 512) & 127); }

__device__ __forceinline__ void cmul(float& xr, float& xi, float ar, float ai) { const float r = xr * ar - xi * ai, i = xr * ai + xi * ar; xr = r; xi = i; }
__device__ __forceinline__ void ssm_disc(const Args& args, int g, int p, float& lr, float& li, float& fre, float& fim) {
    const float dt = expf(args.in[I_LDT][g]), are = args.in[I_ARE][g * 64 + p], aim = args.in[I_AIM][g * 64 + p];
    const float mag = expf(are * dt); float sn, cs; sincos_(aim * dt, sn, cs);
    lr = mag * cs; li = mag * sn; const float den = are * are + aim * aim;
    fre = ((lr - 1.0f) * are + li * aim) / den; fim = (li * are - (lr - 1.0f) * aim) / den;
}
__device__ __forceinline__ void ssm_gen(const Args& args, LAS float* F, bf16* WSs, bf16* WYs, int job, int tid) {
    const int g = job >> 3, part = job & 7;
    LAS float* LR = F; LAS float* LI = F + 1088; LAS float* BR = F + 2176; LAS float* BI = F + 3200; LAS float* KD = F + 4224;
    { const int p = tid & 63;
      const float dt = expf(args.in[I_LDT][g]), are = args.in[I_ARE][g * 64 + p], aim = args.in[I_AIM][g * 64 + p];
      for (int d = tid >> 6; d <= 16; d += 8) { const float mag = expf(are * dt * (float)d); float sn, cs; sincos_(aim * dt * (float)d, sn, cs); LR[d * 64 + p] = mag * cs; LI[d * 64 + p] = mag * sn; }
      if (tid < 64) { float lr, li, fre, fim; ssm_disc(args, g, p, lr, li, fre, fim);
#pragma unroll
          for (int c = 0; c < 16; ++c) { const float br = args.in[I_BRE][(g * 64 + p) * 16 + c], bi = args.in[I_BIM][(g * 64 + p) * 16 + c]; BR[p * 16 + c] = fre * br - fim * bi; BI[p * 16 + c] = fre * bi + fim * br; } }
    }
    __syncthreads();
    for (int e = tid; e < 4096; e += NTHR) { const int d = e >> 8, c = (e >> 4) & 15, c2 = e & 15;
        const float* cre = args.in[I_CRE] + (g * 16 + c) * 64; const float* cim = args.in[I_CIM] + (g * 16 + c) * 64;
        float acc = 0.f;
        for (int p = 0; p < 64; ++p) { const float lr = LR[d * 64 + p], li = LI[d * 64 + p], cr = cre[p], ci = cim[p]; const float xr = cr * lr - ci * li, xi = cr * li + ci * lr; acc += xr * BR[p * 16 + c2] - xi * BI[p * 16 + c2]; }
        if (d == 0 && c == c2) acc += args.in[I_D][g * 16 + c];
        KD[e] = acc; }
    __syncthreads();
    for (int e = tid; e < 32 * 384; e += NTHR) { const int rr = e / 384, k = e % 384, i = 2 * part + (rr >> 4), c = rr & 15; float v;
        if (k < 256) { const int j = k >> 4, c2 = k & 15; v = (j <= i) ? KD[((i - j) << 8) + (c << 4) + c2] : 0.f; }
        else { const int p = (k - 256) & 63; const float lr = LR[(i + 1) * 64 + p], li = LI[(i + 1) * 64 + p], cr = args.in[I_CRE][(g * 16 + c) * 64 + p], ci = args.in[I_CIM][(g * 16 + c) * 64 + p];
            v = (k < 320) ? (cr * lr - ci * li) : -(cr * li + ci * lr); }
        WYs[((size_t)(g * 256 + i * 16 + c)) * 384 + k] = (bf16)f2bf(v); }
    for (int e = tid; e < 16 * 256; e += NTHR) { const int nn = e >> 8, k = e & 255, n = 16 * part + nn, p = n & 63, j = k >> 4, c2 = k & 15;
        const float lr = LR[(15 - j) * 64 + p], li = LI[(15 - j) * 64 + p], br = BR[p * 16 + c2], bi = BI[p * 16 + c2];
        WSs[((size_t)(g * 256 + n)) * 256 + k] = (bf16)f2bf((n < 64) ? (lr * br - li * bi) : (lr * bi + li * br)); }
    for (int e = tid; e < 16 * 32; e += NTHR) *(v4u*)(WSs + ((size_t)(g * 256 + 128 + 16 * part + (e >> 5))) * 256 + 8 * (e & 31)) = (v4u){0u, 0u, 0u, 0u};
    __syncthreads();
}
__device__ __forceinline__ void ssm_carry(const Args& args, const float* SL, bf16* UA, float* out, LAS float* F, int bg, int wave, int lane) {
    const int b = bg >> 5, g = bg & 31, p = lane;
    const float dt = expf(args.in[I_LDT][g]), are = args.in[I_ARE][g * 64 + p], aim = args.in[I_AIM][g * 64 + p];
    float l16r, l16i; { const float mag = expf(are * dt * 16.0f); float sn, cs; sincos_(aim * dt * 16.0f, sn, cs); l16r = mag * cs; l16i = mag * sn; }
    float l256r = l16r, l256i = l16i;
#pragma unroll
    for (int q = 0; q < 4; ++q) cmul(l256r, l256i, l256r, l256i);
    const size_t row0 = (size_t)(g * 1024 + b * 128 + wave * 16);
    const float* slp = SL + row0 * 128 + p;
    float sr[16], si[16];
#pragma unroll
    for (int k = 0; k < 16; ++k) { sr[k] = slp[k * 128]; si[k] = slp[k * 128 + 64]; }
    float tr = 0.f, ti = 0.f;
#pragma unroll
    for (int k = 0; k < 16; ++k) { cmul(tr, ti, l16r, l16i); tr += sr[k]; ti += si[k]; }
    F[wave * 128 + p] = tr; F[wave * 128 + 64 + p] = ti;
    __syncthreads();
    float cr = 0.f, ci = 0.f;
    for (int w = 0; w < wave; ++w) { cmul(cr, ci, l256r, l256i); cr += F[w * 128 + p]; ci += F[w * 128 + 64 + p]; }
    bf16* up = UA + row0 * 384 + 256 + p;
#pragma unroll
    for (int k = 0; k < 16; ++k) { up[k * 384] = (bf16)f2bf(cr); up[k * 384 + 64] = (bf16)f2bf(ci); cmul(cr, ci, l16r, l16i); cr += sr[k]; ci += si[k]; }
    if (wave == 7) { out[O_RP + (b * 32 + g) * 64 + p] = cr; out[O_IP + (b * 32 + g) * 64 + p] = ci; }
    __syncthreads();
}
__device__ __forceinline__ void ssm_sample_item(const Args& args, const bf16* PROJ, bf16* GB, float* out, int it, int lane) {
    const int n = it >> 5, g = it & 31, p = lane;
    float lr, li, fre, fim; ssm_disc(args, g, p, lr, li, fre, fim);
    float bre[16], bim[16], cre[16], cim[16];
#pragma unroll
    for (int c = 0; c < 16; ++c) { const float br = args.in[I_BRE][(g * 64 + p) * 16 + c], bi = args.in[I_BIM][(g * 64 + p) * 16 + c]; bre[c] = fre * br - fim * bi; bim[c] = fre * bi + fim * br;
        cre[c] = args.in[I_CRE][(g * 16 + c) * 64 + p]; cim[c] = args.in[I_CIM][(g * 16 + c) * 64 + p]; }
    float xr = args.in[I_SRE][(n * 32 + g) * 64 + p], xi = args.in[I_SIM][(n * 32 + g) * 64 + p];
    const float dme = (lane < 16) ? args.in[I_D][g * 16 + (lane & 15)] : 0.f;
    for (int j = 0; j < 4; ++j) {
        const size_t row = (size_t)(MP + n * 4 + j);
        const v4u* upp = (const v4u*)(PROJ + row * NPROJ + g * 16);
        const v4u u0 = upp[0], u1 = upp[1];
        const float u[16] = {bflo(u0.x), bfhi(u0.x), bflo(u0.y), bfhi(u0.y), bflo(u0.z), bfhi(u0.z), bflo(u0.w), bfhi(u0.w), bflo(u1.x), bfhi(u1.x), bflo(u1.y), bfhi(u1.y), bflo(u1.z), bfhi(u1.z), bflo(u1.w), bfhi(u1.w)};
        float bur = 0.f, bui = 0.f;
#pragma unroll
        for (int c = 0; c < 16; ++c) { bur = fmaf(bre[c], u[c], bur); bui = fmaf(bim[c], u[c], bui); }
        cmul(xr, xi, lr, li); xr += bur; xi += bui;
        float yme = 0.f, ume = 0.f;
#pragma unroll
        for (int c = 0; c < 16; ++c) { const float yc = wave_sum(cre[c] * xr - cim[c] * xi); yme = (lane == c) ? yc : yme; ume = (lane == c) ? u[c] : ume; }
        if (lane < 16) GB[row * 512 + g * 16 + lane] = (bf16)f2bf(gelu_tanh(yme + dme * ume));
    }
    out[O_RS + (n * 32 + g) * 64 + p] = xr; out[O_IS + (n * 32 + g) * 64 + p] = xi;
}
typedef float f32x16 __attribute__((ext_vector_type(16)));
typedef short s16x4 __attribute__((ext_vector_type(4)));
typedef short v4i16_t __attribute__((ext_vector_type(4)));
constexpr float C2LOG = 0.125f * 1.4426950408889634f;
constexpr float M_INIT = -1e30f;
__device__ __forceinline__ int crow(int r, int h2) { return (r & 3) + 8 * (r >> 2) + 4 * h2; }
__device__ __forceinline__ unsigned cvtpk(float lo, float hi) { unsigned r; asm volatile("v_cvt_pk_bf16_f32 %0, %1, %2" : "=v"(r) : "v"(lo), "v"(hi)); return r; }
__device__ __forceinline__ float ex2(float x) { return __builtin_amdgcn_exp2f(x); }
template <int CTRL> __device__ __forceinline__ float dpp_f(float v) { return __int_as_float(__builtin_amdgcn_update_dpp(0, __float_as_int(v), CTRL, 0xf, 0xf, false)); }
__device__ __forceinline__ float red16(float v) { v += dpp_f<0xB1>(v); v += dpp_f<0x4E>(v); v += dpp_f<0x141>(v); v += dpp_f<0x140>(v); return v; }

__device__ __forceinline__ void attn_prompt_item(const bf16* __restrict__ PROJ, bf16* __restrict__ OP, f32x2* __restrict__ ML, int item, LAS unsigned char* vst, int lane) {
    const int qb = item & 63, bhp = item >> 6, p = bhp % 3, bh = bhp / 3, h = bh & 7, b = bh >> 3;
    const int dsh = 2 * p, d = 1 << dsh, nbr = 64 >> dsh;
    const int r = qb >> (6 - dsh), jb = qb & (nbr - 1);
    const int q32 = lane & 31, h2 = lane >> 5;
    const int tbase = b * 2048 + r;
    const int mrow = tbase + d * (32 * jb + q32);
    bf16x8 qf[4];
    { const bf16* Qp = PROJ + (size_t)mrow * NPROJ + 1024 + h * 64 + 8 * h2;
#pragma unroll
      for (int s = 0; s < 4; ++s) qf[s] = *(const bf16x8*)(Qp + 16 * s); }
    f32x16 o0, o1;
#pragma unroll
    for (int i = 0; i < 16; ++i) { o0[i] = 0.f; o1[i] = 0.f; }
    float m_run = M_INIT, l_run = 0.f;
    const LAS unsigned char* vrd = vst + (4 * h2 + ((lane & 15) >> 2)) * 128 + (16 * ((lane >> 4) & 1) + 4 * (lane & 3)) * 2;
    LAS unsigned char* vwr = vst + (lane >> 3) * 128 + (lane & 7) * 16;
    const int kb_lo = jb > 4 ? jb - 4 : 0;
    for (int kb = kb_lo; kb <= jb; ++kb) {
        bf16x8 kf[4];
        { const bf16* Kp = PROJ + (size_t)(tbase + d * (32 * kb + q32)) * NPROJ + 1536 + h * 64 + 8 * h2;
#pragma unroll
          for (int s = 0; s < 4; ++s) kf[s] = *(const bf16x8*)(Kp + 16 * s); }
        u32x4 vr[4];
#pragma unroll
        for (int i = 0; i < 4; ++i) vr[i] = *(const u32x4*)(PROJ + (size_t)(tbase + d * (32 * kb + 8 * i + (lane >> 3))) * NPROJ + 2048 + h * 64 + 8 * (lane & 7));
        f32x16 st;
#pragma unroll
        for (int i = 0; i < 16; ++i) st[i] = 0.f;
#pragma unroll
        for (int s = 0; s < 4; ++s) st = __builtin_amdgcn_mfma_f32_32x32x16_bf16(kf[s], qf[s], st, 0, 0, 0);
        const bool diag = (kb == jb), edge = (kb + 4 == jb);
        float mx = M_INIT;
#pragma unroll
        for (int i = 0; i < 16; ++i) { const int ki = crow(i, h2); const bool ok = !((diag && ki > q32) || (edge && ki < q32));
            st[i] = ok ? st[i] * C2LOG : -INFINITY; mx = fmaxf(mx, st[i]); }
        mx = fmaxf(mx, __shfl_xor(mx, 32));
        const float mn = fmaxf(m_run, mx), alpha = ex2(m_run - mn);
        m_run = mn;
        float ls = 0.f;
#pragma unroll
        for (int i = 0; i < 16; ++i) { st[i] = ex2(st[i] - mn); ls += st[i]; }
        l_run = l_run * alpha + ls;
#pragma unroll
        for (int i = 0; i < 16; ++i) { o0[i] *= alpha; o1[i] *= alpha; }
        bf16x8 pa[2];
#pragma unroll
        for (int s = 0; s < 2; ++s) { u32x4 w; w.x = cvtpk(st[8 * s], st[8 * s + 1]); w.y = cvtpk(st[8 * s + 2], st[8 * s + 3]); w.z = cvtpk(st[8 * s + 4], st[8 * s + 5]); w.w = cvtpk(st[8 * s + 6], st[8 * s + 7]); pa[s] = __builtin_bit_cast(bf16x8, w); }
#pragma unroll
        for (int i = 0; i < 4; ++i) *(LAS u32x4*)(vwr + i * 1024) = vr[i];
        asm volatile("s_waitcnt lgkmcnt(0)" ::: "memory");
        __builtin_amdgcn_wave_barrier();
#pragma unroll
        for (int s = 0; s < 2; ++s) {
#pragma unroll
            for (int mb = 0; mb < 2; ++mb) {
                const s16x4 lo = __builtin_bit_cast(s16x4, __builtin_amdgcn_ds_read_tr16_b64_v4i16((LAS v4i16_t*)(vrd + s * 2048 + mb * 64)));
                const s16x4 hi = __builtin_bit_cast(s16x4, __builtin_amdgcn_ds_read_tr16_b64_v4i16((LAS v4i16_t*)(vrd + s * 2048 + 1024 + mb * 64)));
                const bf16x8 va = (bf16x8){lo[0], lo[1], lo[2], lo[3], hi[0], hi[1], hi[2], hi[3]};
                if (mb == 0) o0 = __builtin_amdgcn_mfma_f32_32x32x16_bf16(va, pa[s], o0, 0, 0, 0);
                else         o1 = __builtin_amdgcn_mfma_f32_32x32x16_bf16(va, pa[s], o1, 0, 0, 0);
            }
        }
        asm volatile("s_waitcnt lgkmcnt(0)" ::: "memory");
        __builtin_amdgcn_wave_barrier();
    }
    const float lt = l_run + __shfl_xor(l_run, 32), inv = 1.0f / lt;
    bf16* Ob = OP + ((size_t)p * MP + mrow) * 512 + h * 64 + 4 * h2;
#pragma unroll
    for (int g = 0; g < 4; ++g) {
        unsigned long long w0 = (unsigned long long)cvtpk(o0[4 * g] * inv, o0[4 * g + 1] * inv) | ((unsigned long long)cvtpk(o0[4 * g + 2] * inv, o0[4 * g + 3] * inv) << 32);
        unsigned long long w1 = (unsigned long long)cvtpk(o1[4 * g] * inv, o1[4 * g + 1] * inv) | ((unsigned long long)cvtpk(o1[4 * g + 2] * inv, o1[4 * g + 3] * inv) << 32);
        *(unsigned long long*)(Ob + 8 * g) = w0; *(unsigned long long*)(Ob + 32 + 8 * g) = w1;
    }
    if (h2 == 0) ML[((size_t)p * MP + mrow) * 8 + h] = (f32x2){m_run, lt};
}

__device__ __forceinline__ f32x4 bf4_to_f4(const bf16* p) { const unsigned long long w = *(const unsigned long long*)p; return (f32x4){bflo((unsigned)w), bfhi((unsigned)w), bflo((unsigned)(w >> 32)), bfhi((unsigned)(w >> 32))}; }
#define SAMP_UPD(kA, kB, vA, vB, okbits) do { \
    _Pragma("unroll") for (int jq = 0; jq < NQ; ++jq) { \
        _Pragma("unroll") for (int hf = 0; hf < 2; ++hf) { \
            const f32x4 k_ = hf ? (kB) : (kA), v_ = hf ? (vB) : (vA), q_ = q[jq][hf]; \
            float s_ = red16((q_.x * k_.x + q_.y * k_.y) + (q_.z * k_.z + q_.w * k_.w)); \
            s_ = (((okbits) >> jq) & 1u) ? s_ : -INFINITY; \
            const float mn_ = fmaxf(m[jq][hf], s_), al_ = ex2(m[jq][hf] - mn_), pe_ = ex2(s_ - mn_); \
            m[jq][hf] = mn_; l[jq][hf] = l[jq][hf] * al_ + pe_; o[jq][hf] = o[jq][hf] * al_ + v_ * pe_; } } } while (0)
template <int NQ, bool DENSE> __device__ __forceinline__ void samp_run(const bf16* __restrict__ PROJ, const float* __restrict__ ck, const float* __restrict__ cv, float* SPO, f32x2* SPM,
                                                                         int n, int j0, int slot, int r0, int stride, int nlo, int nhi, int lane) {
    f32x4 q[NQ][2], o[NQ][2]; float m[NQ][2], l[NQ][2];
#pragma unroll
    for (int jq = 0; jq < NQ; ++jq) {
        const bf16* qp = PROJ + (size_t)(MP + n * 4 + j0 + jq) * NPROJ + 1024 + 4 * lane;
        q[jq][0] = bf4_to_f4(qp) * C2LOG; q[jq][1] = bf4_to_f4(qp + 256) * C2LOG;
#pragma unroll
        for (int hf = 0; hf < 2; ++hf) { o[jq][hf] = (f32x4){0.f, 0.f, 0.f, 0.f}; m[jq][hf] = M_INIT; l[jq][hf] = 0.f; }
    }
#pragma unroll 2
    for (int i = 0; i < 64; ++i) {
        const int row = r0 + stride * i; const size_t off = (size_t)row * 512;
        const f32x4 kA = *(const f32x4*)(ck + off), kB = *(const f32x4*)(ck + off + 256), vA = *(const f32x4*)(cv + off), vB = *(const f32x4*)(cv + off + 256);
        unsigned okb = 0xFu;
        if (DENSE) okb = 1u | (row >= 1921 ? 2u : 0u) | (row >= 1922 ? 4u : 0u) | (row >= 1923 ? 8u : 0u);
        SAMP_UPD(kA, kB, vA, vB, okb);
    }
    for (int rn = nlo; rn < nhi; ++rn) {
        const bf16* rp = PROJ + (size_t)(MP + n * 4 + rn) * NPROJ + 4 * lane;
        const f32x4 kA = bf4_to_f4(rp + 1536), kB = bf4_to_f4(rp + 1536 + 256), vA = bf4_to_f4(rp + 2048), vB = bf4_to_f4(rp + 2048 + 256);
        unsigned okb = 0xFu;
        if (DENSE) okb = (rn <= 0 ? 1u : 0u) | (rn <= 1 ? 2u : 0u) | (rn <= 2 ? 4u : 0u) | 8u;
        SAMP_UPD(kA, kB, vA, vB, okb);
    }
#pragma unroll
    for (int jq = 0; jq < NQ; ++jq) {
        const size_t rec = ((size_t)(n * 4 + j0 + jq) * 6 + slot);
#pragma unroll
        for (int hf = 0; hf < 2; ++hf) {
            *(f32x4*)(SPO + rec * 512 + hf * 256 + 4 * lane) = o[jq][hf];
            if ((lane & 15) == 0) { f32x2 t; t.x = m[jq][hf]; t.y = l[jq][hf]; SPM[rec * 8 + hf * 4 + (lane >> 4)] = t; }
        }
    }
}
__device__ __forceinline__ void attn_sample_item(const bf16* __restrict__ PROJ, const float* __restrict__ CK, const float* __restrict__ CV, float* SPO, f32x2* SPM, int si, int lane) {
    const int n = si / 18, k = si % 18;
    const float* ck = CK + (size_t)n * 2048 * 512 + 4 * lane; const float* cv = CV + (size_t)n * 2048 * 512 + 4 * lane;
    if (k < 2) {
        samp_run<4, true>(PROJ, ck, cv, SPO, SPM, n, 0, k, 1920 + 64 * k, 1, 0, k ? 4 : 0, lane);
    } else {
        const int kk = k - 2, pat = kk >> 3, j = (kk & 7) >> 1, hf2 = kk & 1;
        const int stride = pat ? 16 : 4, r0 = (pat ? j : 1536 + j) + stride * 64 * hf2;
        samp_run<1, false>(PROJ, ck, cv, SPO, SPM, n, j, 2 + 2 * pat + hf2, r0, stride, j, hf2 ? j + 1 : j, lane);
    }
}
__device__ __forceinline__ void attn_combine_row(const bf16* __restrict__ PROJ, const bf16* __restrict__ OP, const f32x2* __restrict__ ML, const float* __restrict__ SPO, const f32x2* __restrict__ SPM,
                                                 const float* __restrict__ ga, bf16* __restrict__ Y2, int m, int lane) {
    const int hd = lane >> 3;
    float acc[8];
    if (m < MP) {
        f32x2 ml[3]; float bm = M_INIT;
#pragma unroll
        for (int p = 0; p < 3; ++p) { ml[p] = ML[((size_t)p * MP + m) * 8 + hd]; bm = fmaxf(bm, ml[p].x); }
        float w[3], den = 0.f;
#pragma unroll
        for (int p = 0; p < 3; ++p) { w[p] = ex2(ml[p].x - bm) * ml[p].y; den += w[p]; }
        const float inv = 1.0f / den;
#pragma unroll
        for (int i = 0; i < 8; ++i) acc[i] = 0.f;
#pragma unroll
        for (int p = 0; p < 3; ++p) { const u32x4 v = *(const u32x4*)(OP + ((size_t)p * MP + m) * 512 + 8 * lane); const float ww = w[p] * inv;
            acc[0] += ww * bflo(v.x); acc[1] += ww * bfhi(v.x); acc[2] += ww * bflo(v.y); acc[3] += ww * bfhi(v.y); acc[4] += ww * bflo(v.z); acc[5] += ww * bfhi(v.z); acc[6] += ww * bflo(v.w); acc[7] += ww * bfhi(v.w); }
    } else {
        const size_t rec0 = (size_t)(m - MP) * 6;
        f32x2 ml[6]; float bm = M_INIT;
#pragma unroll
        for (int s = 0; s < 6; ++s) { ml[s] = SPM[(rec0 + s) * 8 + hd]; bm = fmaxf(bm, ml[s].x); }
        float w[6], den = 0.f;
#pragma unroll
        for (int s = 0; s < 6; ++s) { w[s] = ex2(ml[s].x - bm); den += w[s] * ml[s].y; }
        const float inv = 1.0f / den;
#pragma unroll
        for (int i = 0; i < 8; ++i) acc[i] = 0.f;
#pragma unroll
        for (int s = 0; s < 6; ++s) { const f32x4 a = *(const f32x4*)(SPO + (rec0 + s) * 512 + 8 * lane), b = *(const f32x4*)(SPO + (rec0 + s) * 512 + 8 * lane + 4); const float ww = w[s] * inv;
            acc[0] += ww * a.x; acc[1] += ww * a.y; acc[2] += ww * a.z; acc[3] += ww * a.w; acc[4] += ww * b.x; acc[5] += ww * b.y; acc[6] += ww * b.z; acc[7] += ww * b.w; }
    }
    const u32x4 zw = *(const u32x4*)(PROJ + (size_t)m * NPROJ + 2560 + 8 * lane);
    const float z[8] = {bflo(zw.x), bfhi(zw.x), bflo(zw.y), bfhi(zw.y), bflo(zw.z), bfhi(zw.z), bflo(zw.w), bfhi(zw.w)};
    float ss = 0.f;
#pragma unroll
    for (int i = 0; i < 8; ++i) { acc[i] *= silu_(z[i]); ss += acc[i] * acc[i]; }
    const float rs = 1.0f / sqrtf(wave_sum(ss) * (1.f / 512) + RMS_EPS);
    const f32x4 g0 = *(const f32x4*)(ga + 8 * lane), g1 = *(const f32x4*)(ga + 8 * lane + 4);
    u32x4 o; o.x = pk2(acc[0] * rs * g0.x, acc[1] * rs * g0.y); o.y = pk2(acc[2] * rs * g0.z, acc[3] * rs * g0.w); o.z = pk2(acc[4] * rs * g1.x, acc[5] * rs * g1.y); o.w = pk2(acc[6] * rs * g1.z, acc[7] * rs * g1.w);
    *(u32x4*)(Y2 + (size_t)m * DM + 512 + 8 * lane) = o;
}

__device__ __forceinline__ void branch_norm(const float* src, const float* gg, bf16* Y2, int coff, int gw, int NGW, int lane) {
    for (int m = gw; m < MT; m += NGW) {
        const f32x4 a = *((const f32x4*)(src + (size_t)m * 512) + lane), b = *((const f32x4*)(src + (size_t)m * 512) + 64 + lane);
        const float s = (a.x * a.x + a.y * a.y) + (a.z * a.z + a.w * a.w) + (b.x * b.x + b.y * b.y) + (b.z * b.z + b.w * b.w);
        const float rs = 1.0f / sqrtf(wave_sum(s) * (1.f / 512) + RMS_EPS);
        const f32x4 g0 = *((const f32x4*)gg + lane), g1 = *((const f32x4*)gg + 64 + lane);
        unsigned long long* o8 = (unsigned long long*)(Y2 + (size_t)m * DM + coff);
        o8[lane] = (unsigned long long)pk2(a.x * rs * g0.x, a.y * rs * g0.y) | ((unsigned long long)pk2(a.z * rs * g0.z, a.w * rs * g0.w) << 32);
        o8[64 + lane] = (unsigned long long)pk2(b.x * rs * g1.x, b.y * rs * g1.y) | ((unsigned long long)pk2(b.z * rs * g1.z, b.w * rs * g1.w) << 32);
    }
}

__global__ void __launch_bounds__(NTHR, 2) fwd(Args args) {
    extern __shared__ __attribute__((aligned(16))) unsigned char lds[];
    LAS unsigned char* L = (LAS unsigned char*)lds;
    const int wave = __builtin_amdgcn_readfirstlane(threadIdx.x >> 6);
    const int G = gridDim.x, gw = blockIdx.x * NWAVES + wave, NGW = G * NWAVES;
#define LANE_TID const int lane = lane_id(), tid = wave * 64 + lane; (void)tid
    unsigned char* ws = args.ws; float* out = args.out;
    bf16* Win_t = (bf16*)(ws + WS_WIN); bf16* Wglu_t = (bf16*)(ws + WS_WGLU); bf16* Wout_t = (bf16*)(ws + WS_WOUT);
    bf16* XN = (bf16*)(ws + WS_XN); bf16* PROJ = (bf16*)(ws + WS_PROJ); bf16* GB = (bf16*)(ws + WS_G); bf16* Y2 = (bf16*)(ws + WS_Y2);
    bf16* OP = (bf16*)(ws + WS_OP); f32x2* ML = (f32x2*)(ws + WS_ML); float* SPO = (float*)(ws + WS_SPO); f32x2* SPM = (f32x2*)(ws + WS_SPM);
    float* YAR = (float*)(ws + WS_YAR); float* YSR = (float*)(ws + WS_YSR); bf16* UA = (bf16*)(ws + WS_UA); bf16* WSs = (bf16*)(ws + WS_WSS); bf16* WYs = (bf16*)(ws + WS_WYS); float* SL = (float*)(ws + WS_SL);
    const int lo = args.ph_lo, hi = args.ph_hi;
#define IN(k) (lo <= (k) && (k) < hi)
#define SEAM(k) do { if (IN(k) && IN((k) + 1)) xcd_barrier(bar); } while (0)
    gu32* ctl = (gu32*)(ws + WS_CTL);
    { LANE_TID; for (int u = tid; u < (LDS_BYTES - LDSCTL_OFF) / 4; u += NTHR) ((LAS unsigned*)(L + LDSCTL_OFF))[u] = 0u; }
    __syncthreads();
    XcdBarrier bar; bar.bar = (unsigned*)(ctl + CW_BAR); bar.x = 0; bar.st = nullptr; bar.w = wave;
    if (hi - lo > 1) bar = xcd_barrier_post((unsigned*)(ctl + CW_BAR), (volatile LAS unsigned*)(L + MISC_OFF) + 8, wave);

    if (IN(0)) {
        LANE_TID;
        for (int job = blockIdx.x; job < 256; job += G) ssm_gen(args, (LAS float*)(L + RING_OFF), WSs, WYs, job, tid);
        LAS float* scr = (LAS float*)(L + RING_OFF + wave * 16384);
        constexpr int I_A = 16 * 96, I_B = 8 * 32, I_C = 16 * 32;
        for (int it = gw; it < I_A + I_B + I_C; it += NGW) {
            int r = it;
            if (r < I_A) { const int kb = r / 96, nb = r % 96; p0_transpose_item(args.in[I_WIN], 1024, 3072, Win_t, scr, 64 * kb, 32 * nb, 32 * nb, lane); continue; } r -= I_A;
            if (r < I_B) { const int kb = r / 32, nb = r % 32; p0_transpose_item(args.in[I_WGLU], 512, 1024, Wglu_t, scr, 64 * kb, 32 * nb, glu_perm(32 * nb), lane); continue; } r -= I_B;
            { const int kb = r / 32, nb = r % 32; p0_transpose_item(args.in[I_WOUT], 1024, 1024, Wout_t, scr, 64 * kb, 32 * nb, 32 * nb, lane); }
        }
        const float* gin = args.in[I_GIN];
        for (int m = gw; m < MT; m += NGW) {
            const float* xrow = (m < MP) ? args.in[I_XP] + (size_t)m * DM : args.in[I_XS] + (size_t)(m - MP) * DM;
            const GAS f32x4* xr = (const GAS f32x4*)xrow + lane;
            f32x4 v[4]; float s = 0.f;
#pragma unroll
            for (int j = 0; j < 4; ++j) { v[j] = xr[64 * j]; s += (v[j].x * v[j].x + v[j].y * v[j].y) + (v[j].z * v[j].z + v[j].w * v[j].w); }
            const float rs = 1.0f / sqrtf(wave_sum(s) * (1.f / DM) + RMS_EPS);
            GAS unsigned long long* o8 = (GAS unsigned long long*)(XN + (size_t)m * DM) + lane;
#pragma unroll
            for (int j = 0; j < 4; ++j) { const f32x4 g4 = *((const f32x4*)gin + lane + 64 * j);
                o8[64 * j] = (unsigned long long)pk2(v[j].x * rs * g4.x, v[j].y * rs * g4.y) | ((unsigned long long)pk2(v[j].z * rs * g4.z, v[j].w * rs * g4.w) << 32); }
        }
    }
    SEAM(0);
    if (IN(1)) {
        pg8::Gemm g{XN, Win_t, MT, NPROJ, DM, DM, DM}; pg8::StaticOrder S; S.init(MT, NPROJ, G, (int)blockIdx.x);
        pg8::EpiProj E{PROJ, out, UA};
        pg8::gemm_phase<pg8::EpiProj, pg8::StaticOrder, true, true>(L + RING_OFF, g, S, E, wave);
    }
    SEAM(1);
    if (IN(2)) {
        LANE_TID;
        { pg8::Gemm g{UA, WSs, 32768, 8192, 256, 384, 256}; pg8::SsmOrder S{G, (int)blockIdx.x}; pg8::EpiSsmS E{SL};
          pg8::gemm_phase<pg8::EpiSsmS, pg8::SsmOrder, true, true>(L + RING_OFF, g, S, E, wave); }
        for (int it = gw; it < 128 * 32; it += NGW) ssm_sample_item(args, PROJ, GB, out, it, lane);
        LAS unsigned char* vst = L + RING_OFF + wave * 4096;
        for (int si = gw; si < 128 * 18; si += NGW) attn_sample_item(PROJ, args.in[I_CK], args.in[I_CV], SPO, SPM, si, lane);
        for (int U = blockIdx.x; U < 1536; U += G) attn_prompt_item(PROJ, OP, ML, U * 8 + wave, vst, lane);
    }
    SEAM(2);
    if (IN(3)) {
        LANE_TID;
        for (int bg = blockIdx.x; bg < 256; bg += G) ssm_carry(args, SL, UA, out, (LAS float*)(L + RING_OFF), bg, wave, lane);
        for (int m = gw; m < MT; m += NGW) attn_combine_row(PROJ, OP, ML, SPO, SPM, args.in[I_GA], Y2, m, lane);
    }
    SEAM(3);
    if (IN(4)) {
        pg8::Gemm g{UA, WYs, 32768, 8192, 384, 384, 384}; pg8::SsmOrder S{G, (int)blockIdx.x}; pg8::EpiSsmY E{GB};
        pg8::gemm_phase<pg8::EpiSsmY, pg8::SsmOrder, true, true>(L + RING_OFF, g, S, E, wave);
    }
    SEAM(4);
    if (IN(5)) {
        pg8::Gemm g{GB, Wglu_t, MT, 1024, 512, 512, 512}; pg8::StaticOrder S; S.init(MT, 1024, G, (int)blockIdx.x);
        pg8::EpiGlu E{PROJ, args.in[I_BGLU], YSR};
        pg8::gemm_phase<pg8::EpiGlu, pg8::StaticOrder, true, true>(L + RING_OFF, g, S, E, wave);
    }
    SEAM(5);
    if (IN(6)) { LANE_TID; branch_norm(YSR, args.in[I_GS], Y2, 0, gw, NGW, lane); }
    SEAM(6);
    if (IN(7)) {
        pg8::Gemm g{Y2, Wout_t, MT, DM, DM, DM, DM}; pg8::StaticOrder S; S.init(MT, DM, G, (int)blockIdx.x);
        pg8::EpiOut E{args.in[I_XP], args.in[I_XS], out};
        pg8::gemm_phase<pg8::EpiOut, pg8::StaticOrder, true, true>(L + RING_OFF, g, S, E, wave);
    }
    SEAM(7);
    if (IN(8)) {
        LANE_TID;
        const float* gf = args.in[I_GF];
        for (int m = gw; m < MT; m += NGW) {
            GAS f32x4* yr = (GAS f32x4*)(out + O_YP + (size_t)m * DM) + lane;
            f32x4 v[4]; float s = 0.f;
#pragma unroll
            for (int j = 0; j < 4; ++j) { v[j] = yr[64 * j]; s += (v[j].x * v[j].x + v[j].y * v[j].y) + (v[j].z * v[j].z + v[j].w * v[j].w); }
            const float rs = 1.0f / sqrtf(wave_sum(s) * (1.f / DM) + RMS_EPS);
#pragma unroll
            for (int j = 0; j < 4; ++j) { const f32x4 g4 = *((const f32x4*)gf + lane + 64 * j); yr[64 * j] = v[j] * rs * g4; }
        }
    }
#undef IN
#undef SEAM
#undef LANE_TID
}

extern "C" void kernel_launch(void* const* d_in, const int* in_sizes, int n_in, void* d_out, int out_size, void* d_ws, size_t ws_size, hipStream_t stream) {
    static int grid = 0;
    if (grid == 0) {
        if (n_in != 22 || out_size != (int)O_END || ws_size < WS_END) { fprintf(stderr, "kernel_launch: unexpected shapes n_in %d out %d ws %zu\n", n_in, out_size, ws_size); grid = -1; return; }
        int dev = 0, cus = 0, per_cu = 0;
        if (hipGetDevice(&dev) != hipSuccess || hipDeviceGetAttribute(&cus, hipDeviceAttributeMultiprocessorCount, dev) != hipSuccess) { grid = -1; return; }
        if (hipFuncSetAttribute((const void*)fwd, hipFuncAttributeMaxDynamicSharedMemorySize, LDS_BYTES) != hipSuccess) { fprintf(stderr, "kernel_launch: hipFuncSetAttribute failed\n"); grid = -1; return; }
        if (hipOccupancyMaxActiveBlocksPerMultiprocessor(&per_cu, (const void*)fwd, NTHR, LDS_BYTES) != hipSuccess || per_cu < 1) fprintf(stderr, "kernel_launch: occupancy query says %d\n", per_cu);
        (void)hipGetLastError();
        grid = cus;
    }
    if (grid < 0) return;
    (void)hipMemsetAsync((char*)d_ws + WS_CTL, 0, CTL_ZERO_BYTES, stream);
    Args a{};
    for (int i = 0; i < 22; ++i) a.in[i] = (const float*)d_in[i];
    a.out = (float*)d_out; a.ws = (unsigned char*)d_ws;
#if defined(MK_PER_PHASE)
    for (int ph = 0; ph < NPHASE; ++ph) { a.ph_lo = ph; a.ph_hi = ph + 1; hipLaunchKernelGGL(fwd, dim3(grid), dim3(NTHR), LDS_BYTES, stream, a); }
#else
    a.ph_lo = 0; a.ph_hi = NPHASE;
    hipLaunchKernelGGL(fwd, dim3(grid), dim3(NTHR), LDS_BYTES, stream, a);
#endif
}
```

```cpp
#include <hip/hip_runtime.h>
#include <cstdio>
#include <cstdint>
constexpr size_t O_YP = 0, O_YS = 16777216, O_KP = 17301504, O_VP = 25690112, O_RP = 34078720, O_IP = 34095104,
                 O_KS = 34111488, O_VS = 34373632, O_RS = 34635776, O_IS = 34897920, O_END = 35160064;
constexpr int MP = 16384, MS = 512, MT = MP + MS;
constexpr int DM = 1024, NPROJ = 3072;
__device__ __forceinline__ int lane_id() { int l; asm volatile("v_mbcnt_lo_u32_b32 %0, -1, 0\n\tv_mbcnt_hi_u32_b32 %0, -1, %0" : "=v"(l)); return l; }
namespace pg8 {
#define PG8_LAS __attribute__((address_space(3)))
typedef unsigned short bf16_t;
typedef short bf16x8 __attribute__((ext_vector_type(8)));
typedef float f32x4 __attribute__((ext_vector_type(4)));
typedef unsigned u32x4 __attribute__((ext_vector_type(4)));
constexpr int BM = 256, BK = 64, HALF = 128, HTB = HALF * BK * 2  , STAGE_BYTES = 8 * HTB, NXCD = 8, WGM = 8;

__host__ __device__ __forceinline__ int lds_byte(int r, int c) { const int st = (r >> 4) * 2 + (c >> 5), rr = r & 15, cc = c & 31, ob = rr * 64 + cc * 2; return st * 1024 + (ob ^ (((ob >> 9) & 1) << 5)); }
__host__ __device__ __forceinline__ void stage_rc(int b, int& R, int& C) { const int st = b / 1024, sb = b % 1024, swz = sb ^ (((sb >> 9) & 1) << 5); R = (st >> 1) * 16 + swz / 64; C = (st & 1) * 32 + (swz % 64) / 2; }
__host__ __device__ __forceinline__ int perm32(int rho) { const int n = rho >> 4, i = rho & 15; return 8 * (i >> 2) + 4 * n + (i & 3); }

struct Unit { int pm, pn; };
struct Gemm { const bf16_t* A; const bf16_t* Bt; int M, N, K, lda, ldb; };

struct StaticOrder {
    int nM, nN, nwg, G, c;
    __host__ __device__ void init(int M, int N, int G_, int c_) { nM = M / BM; nN = N / BM; nwg = nM * nN; G = G_; c = c_; }
    __host__ __device__ bool next(int i, Unit& u) const {
        const long L = (long)i * G + c; if (L >= nwg) return false;
        int wgid = (int)L; { const int q = nwg / NXCD, r = nwg % NXCD, xcd = wgid % NXCD, off = wgid / NXCD; wgid = (xcd < r ? xcd * (q + 1) : r * (q + 1) + (xcd - r) * q) + off; }
        const int nig = WGM * nN, gid = wgid / nig, fm = gid * WGM, gsz = (nM - fm) < WGM ? (nM - fm) : WGM;
        u.pm = fm + ((wgid % nig) % gsz); u.pn = (wgid % nig) / gsz; return true;
    }
    __device__ __forceinline__ void a_ready(const Unit&) const {}
    __device__ __forceinline__ void done(const Unit&) const {}
};

__device__ __forceinline__ unsigned cvt_pk_bf16(float lo, float hi) { unsigned r; asm volatile("v_cvt_pk_bf16_f32 %0, %1, %2" : "=v"(r) : "v"(lo), "v"(hi)); return r; }
typedef float f32x2 __attribute__((ext_vector_type(2)));
typedef unsigned u32x4 __attribute__((ext_vector_type(4)));
__device__ __forceinline__ float bf2f(unsigned short u) { return __uint_as_float(((unsigned)u) << 16); }
__device__ __forceinline__ float bflo(unsigned w) { return __uint_as_float(w << 16); }
__device__ __forceinline__ float bfhi(unsigned w) { return __uint_as_float(w & 0xffff0000u); }
__device__ __forceinline__ float sigmoidf_(float x) { return 1.0f / (1.0f + __expf(-x)); }
struct EpiProj {
    static constexpr bool PERM = true, AFTER_DRAIN = false;
    bf16_t* P; float* out; bf16_t* UA; int pm_off;
    __device__ __forceinline__ void operator()(const f32x4 (&acc)[2][2][4][2], const Unit& u0, int wr, int wc, int fr, int fq) const {
        Unit u; u.pm = u0.pm + pm_off; u.pn = u0.pn;
        const int row0 = u.pm * BM + wr * 64 + fr, col0 = u.pn * BM + wc * 32 + 8 * fq;
        if (u.pn < 2 && u.pm < 64) {
#pragma unroll
            for (int ai = 0; ai < 2; ++ai)
#pragma unroll
                for (int m = 0; m < 4; ++m) {
                    const int row = row0 + ai * HALF + m * 16, ch = ((row >> 11) << 7) + ((row & 2047) >> 4), tk = row & 15;
#pragma unroll
                    for (int bj = 0; bj < 2; ++bj) {
                        const int col = col0 + bj * HALF, g = col >> 4, c0 = col & 15;
                        const f32x4 v0 = acc[ai][bj][m][0], v1 = acc[ai][bj][m][1];
                        u32x4 w; w.x = cvt_pk_bf16(v0[0], v0[1]); w.y = cvt_pk_bf16(v0[2], v0[3]); w.z = cvt_pk_bf16(v1[0], v1[1]); w.w = cvt_pk_bf16(v1[2], v1[3]);
                        *(u32x4*)(UA + ((size_t)(g * 1024 + ch)) * 384 + tk * 16 + c0) = w;
                    }
                }
            return;
        }
        float* fo = nullptr;
        if (u.pn >= 6 && u.pn < 10) {
            const bool isv = u.pn >= 8; const int cb = isv ? 2048 : 1536;
            if (u.pm < 64) fo = out + (isv ? O_VP : O_KP) + (size_t)row0 * 512 + (col0 - cb);
            else           fo = out + (isv ? O_VS : O_KS) + (size_t)(row0 - MP) * 512 + (col0 - cb);
        }
#pragma unroll
        for (int ai = 0; ai < 2; ++ai)
#pragma unroll
            for (int m = 0; m < 4; ++m) {
                const int rr = ai * HALF + m * 16;
                bf16_t* rowp = P + (size_t)(row0 + rr) * NPROJ + col0;
#pragma unroll
                for (int bj = 0; bj < 2; ++bj) {
                    const f32x4 v0 = acc[ai][bj][m][0], v1 = acc[ai][bj][m][1];
                    u32x4 w; w.x = cvt_pk_bf16(v0[0], v0[1]); w.y = cvt_pk_bf16(v0[2], v0[3]); w.z = cvt_pk_bf16(v1[0], v1[1]); w.w = cvt_pk_bf16(v1[2], v1[3]);
                    *(u32x4*)(rowp + bj * HALF) = w;
                    if (fo) { float* f = fo + (size_t)rr * 512 + bj * HALF; *(f32x4*)f = v0; *(f32x4*)(f + 4) = v1; }
                }
            }
    }
};
struct SsmOrder {
    int G, c;
    __device__ __forceinline__ bool next(int i, Unit& u) const { const int L = i * G + c; if (L >= 128) return false; u.pm = L; u.pn = L >> 2; return true; }
    __device__ __forceinline__ void a_ready(const Unit&) const {}
    __device__ __forceinline__ void done(const Unit&) const {}
};
struct SmallOrder {
    int first, nN, count, c;
    __device__ __forceinline__ bool next(int i, Unit& u) const { const int L = c - first; if (i != 0 || L < 0 || L >= count) return false; u.pm = L / nN; u.pn = L % nN; return true; }
    __device__ __forceinline__ void a_ready(const Unit&) const {}
    __device__ __forceinline__ void done(const Unit&) const {}
};
struct EpiSsmS {
    static constexpr bool PERM = false, AFTER_DRAIN = false;
    float* SL;
    __device__ __forceinline__ void operator()(const f32x4 (&acc)[2][2][4][2], const Unit& u, int wr, int wc, int fr, int fq) const {
        const int row0 = u.pm * BM + wr * 64 + fr, col0 = wc * 32 + 4 * fq;
#pragma unroll
        for (int ai = 0; ai < 2; ++ai)
#pragma unroll
            for (int m = 0; m < 4; ++m)
#pragma unroll
                for (int n = 0; n < 2; ++n) *(f32x4*)(SL + (size_t)(row0 + ai * HALF + m * 16) * 128 + col0 + n * 16) = acc[ai][0][m][n];
    }
};
__device__ __forceinline__ float gelu_t(float x) { const float z = 0.7978845608028654f * (x + 0.044715f * x * x * x); const float t = __expf(2.0f * z); return 0.5f * x * (2.0f - 2.0f / (t + 1.0f)); }
struct EpiSsmY {
    static constexpr bool PERM = true, AFTER_DRAIN = false;
    bf16_t* GB;
    __device__ __forceinline__ void operator()(const f32x4 (&acc)[2][2][4][2], const Unit& u, int wr, int wc, int fr, int fq) const {
        const int g = u.pn, chl0 = (u.pm & 3) * BM + wr * 64 + fr;
#pragma unroll
        for (int ai = 0; ai < 2; ++ai)
#pragma unroll
            for (int m = 0; m < 4; ++m) {
                const int ch = chl0 + ai * HALF + m * 16, b = ch >> 7, tk = (ch & 127) * 16;
#pragma unroll
                for (int bj = 0; bj < 2; ++bj) {
                    const int col0 = bj * HALF + wc * 32 + 8 * fq, i = col0 >> 4, c0 = col0 & 15;
                    const f32x4 v0 = acc[ai][bj][m][0], v1 = acc[ai][bj][m][1];
                    u32x4 w; w.x = cvt_pk_bf16(gelu_t(v0[0]), gelu_t(v0[1])); w.y = cvt_pk_bf16(gelu_t(v0[2]), gelu_t(v0[3])); w.z = cvt_pk_bf16(gelu_t(v1[0]), gelu_t(v1[1])); w.w = cvt_pk_bf16(gelu_t(v1[2]), gelu_t(v1[3]));
                    *(u32x4*)(GB + (size_t)(b * 2048 + tk + i) * 512 + g * 16 + c0) = w;
                }
                __builtin_amdgcn_sched_barrier(0);
            }
    }
};
struct EpiGlu {
    static constexpr bool PERM = true, AFTER_DRAIN = false;
    const bf16_t* P; const float* bglu; const float* gs; bf16_t* Y2; float* rowss; int pm_off;
    __device__ __forceinline__ void operator()(const f32x4 (&acc)[2][2][4][2], const Unit& u, int wr, int wc, int fr, int fq) const {
        const int row0 = (u.pm + pm_off) * BM + wr * 64 + fr, cv0 = u.pn * HALF + wc * 32 + 8 * fq;
        const f32x4 bv0 = *(const f32x4*)(bglu + cv0), bv1 = *(const f32x4*)(bglu + cv0 + 4), bg0 = *(const f32x4*)(bglu + 512 + cv0), bg1 = *(const f32x4*)(bglu + 512 + cv0 + 4);
        const f32x4 g0 = *(const f32x4*)(gs + cv0), g1 = *(const f32x4*)(gs + cv0 + 4);
#pragma unroll
        for (int ai = 0; ai < 2; ++ai)
#pragma unroll
            for (int m = 0; m < 4; ++m) {
                const int row = row0 + ai * HALF + m * 16;
                const u32x4 zw = *(const u32x4*)(P + (size_t)row * NPROJ + 512 + cv0);
                const float z[8] = {bflo(zw.x), bfhi(zw.x), bflo(zw.y), bfhi(zw.y), bflo(zw.z), bfhi(zw.z), bflo(zw.w), bfhi(zw.w)};
                f32x4 o0, o1;
#pragma unroll
                for (int i = 0; i < 4; ++i) {
                    const float va = acc[ai][0][m][0][i] + bv0[i], ga = acc[ai][1][m][0][i] + bg0[i];
                    const float vb = acc[ai][0][m][1][i] + bv1[i], gb = acc[ai][1][m][1][i] + bg1[i];
                    o0[i] = va * sigmoidf_(ga) * (z[i] * sigmoidf_(z[i]));
                    o1[i] = vb * sigmoidf_(gb) * (z[4 + i] * sigmoidf_(z[4 + i]));
                }
                float ss = (o0[0] * o0[0] + o0[1] * o0[1]) + (o0[2] * o0[2] + o0[3] * o0[3]) + (o1[0] * o1[0] + o1[1] * o1[1]) + (o1[2] * o1[2] + o1[3] * o1[3]);
                ss += __shfl_xor(ss, 16); ss += __shfl_xor(ss, 32);
                if (fq == 0) atomicAdd(rowss + row, ss);
                o0 = o0 * g0; o1 = o1 * g1;
                u32x4 w; w.x = cvt_pk_bf16(o0[0], o0[1]); w.y = cvt_pk_bf16(o0[2], o0[3]); w.z = cvt_pk_bf16(o1[0], o1[1]); w.w = cvt_pk_bf16(o1[2], o1[3]);
                *(u32x4*)(Y2 + (size_t)row * DM + cv0) = w;
            }
    }
};
struct EpiOut {
    static constexpr bool PERM = false, AFTER_DRAIN = false;
    const float* xp; const float* xs; float* out; int pm_off;
    __device__ __forceinline__ void operator()(const f32x4 (&acc)[2][2][4][2], const Unit& u0, int wr, int wc, int fr, int fq) const {
        Unit u; u.pm = u0.pm + pm_off; u.pn = u0.pn;
        const int row0 = u.pm * BM + wr * 64 + fr, col0 = u.pn * BM + wc * 32 + 4 * fq;
        const float* xb = (u.pm < 64) ? xp + (size_t)row0 * DM : xs + (size_t)(row0 - MP) * DM;
        float* ob = out + O_YP + (size_t)row0 * DM;
#pragma unroll
        for (int ai = 0; ai < 2; ++ai)
#pragma unroll
            for (int m = 0; m < 4; ++m) {
                const size_t ro = (size_t)(ai * HALF + m * 16) * DM + col0;
#pragma unroll
                for (int bj = 0; bj < 2; ++bj)
#pragma unroll
                    for (int n = 0; n < 2; ++n) { const size_t o = ro + bj * HALF + n * 16; *(f32x4*)(ob + o) = *(const f32x4*)(xb + o) + acc[ai][bj][m][n]; }
            }
    }
};
struct NoHook { static constexpr bool ON = false; __device__ __forceinline__ void apply(f32x4 (&)[2][2][4][2], const Unit&, int, int) const {} };
struct RowScaleHook {
    static constexpr bool ON = true;
    const float* rowss; int row_off;
    __device__ __forceinline__ void apply(f32x4 (&acc)[2][2][4][2], const Unit& u, int wr, int fr) const {
        const float* rp = rowss + row_off + u.pm * BM + wr * 64 + fr;
#pragma unroll
        for (int ai = 0; ai < 2; ++ai)
#pragma unroll
            for (int m = 0; m < 4; ++m) { const float rs = 1.0f / sqrtf(rp[ai * HALF + m * 16] * (1.0f / 512.0f) + 1e-6f);
#pragma unroll
                for (int bj = 0; bj < 2; ++bj)
#pragma unroll
                    for (int n = 0; n < 2; ++n) acc[ai][bj][m][n] *= rs; }
    }
};
template <class Epi, class Sched, bool ALIGN_EPI = false, bool SP2 = false, class Hook = NoHook>
__device__ __forceinline__ void gemm_phase(PG8_LAS unsigned char* lds, const Gemm g, const Sched& S, const Epi& E, const int wid, const Hook H = Hook(), const int hook_t = -1) {
    const int lane = lane_id(), tid = wid * 64 + lane, wr = wid >> 2, wc = wid & 3, fr = lane & 15, fq = lane >> 4;
    const int K = g.K, nt = K / BK;
    unsigned voffA[2], voffB[2];
#pragma unroll
    for (int i = 0; i < 2; ++i) { int R, C; stage_rc(tid * 16 + i * 8192, R, C); const int Rb = Epi::PERM ? ((R & ~31) + perm32(R & 31)) : R;
        voffA[i] = (unsigned)(R * g.lda + C) * 2u; voffB[i] = (unsigned)(Rb * g.ldb + C) * 2u; }
    const size_t kstep = (size_t)(BK * 2);
    const size_t hstepA = (size_t)HALF * g.lda * 2, hstepB = (size_t)HALF * g.ldb * 2;
    const size_t tstepA = 2 * hstepA, tstepB = 2 * hstepB;
    const unsigned ldsw = (unsigned)wid * 1024u;
    const int aoff = lds_byte(wr * 64 + fr, fq * 8), boff = lds_byte(wc * 32 + fr, fq * 8);
#define PG8_SA(b, h) (((b) * 2 + (h)) * HTB)
#define PG8_SB(b, h) ((4 + (b) * 2 + (h)) * HTB)
#define PG8_STAGE(bufoff, gbase, voff) do { _Pragma("unroll") for (int _i = 0; _i < 2; ++_i) \
        __builtin_amdgcn_global_load_lds((const unsigned*)((const char*)(gbase) + (voff)[_i]), (PG8_LAS unsigned*)(lds + (bufoff) + ldsw + _i * 8192), 16, 0, 0); } while (0)
#define PG8_LDA(dst, b, h) do { _Pragma("unroll") for (int m = 0; m < 4; ++m) _Pragma("unroll") for (int k = 0; k < 2; ++k) dst[m][k] = *(const PG8_LAS bf16x8*)(lds + PG8_SA(b, h) + aoff + m * 2048 + k * 1024); } while (0)
#define PG8_LDB(dst, b, h) do { _Pragma("unroll") for (int n = 0; n < 2; ++n) _Pragma("unroll") for (int k = 0; k < 2; ++k) dst[n][k] = *(const PG8_LAS bf16x8*)(lds + PG8_SB(b, h) + boff + n * 2048 + k * 1024); } while (0)
#define PG8_MMA(ai, bj, At, Bt) do { __builtin_amdgcn_s_setprio(1); _Pragma("unroll") for (int m = 0; m < 4; ++m) _Pragma("unroll") for (int n = 0; n < 2; ++n) _Pragma("unroll") for (int k = 0; k < 2; ++k) \
        acc[ai][bj][m][n] = __builtin_amdgcn_mfma_f32_16x16x32_bf16(Bt[n][k], At[m][k], acc[ai][bj][m][n], 0, 0, 0); __builtin_amdgcn_s_setprio(0); } while (0)
#define PG8_WAIT_V(n) asm volatile("s_waitcnt vmcnt(" #n ")" ::: "memory")
#define PG8_WAIT_L(n) asm volatile("s_waitcnt lgkmcnt(" #n ")" ::: "memory")
#define PG8_BAR __builtin_amdgcn_s_barrier()
#define PG8_SCHED __builtin_amdgcn_sched_barrier(0)
    Unit cur, nxt; int ui = 0;
    if (!S.next(0, cur)) return;
    f32x4 acc[2][2][4][2];
#pragma unroll
    for (int a = 0; a < 2; ++a)
#pragma unroll
        for (int b = 0; b < 2; ++b)
#pragma unroll
            for (int m = 0; m < 4; ++m)
#pragma unroll
                for (int n = 0; n < 2; ++n) acc[a][b][m][n] = (f32x4){0.f, 0.f, 0.f, 0.f};
    bf16x8 At[4][2], B0[2][2], B1[2][2];
    const char* cA = (const char*)g.A + (size_t)cur.pm * tstepA; const char* cB = (const char*)g.Bt + (size_t)cur.pn * tstepB;
    S.a_ready(cur);
    if constexpr (SP2) {
        PG8_STAGE(PG8_SB(0, 0), cB, voffB); PG8_STAGE(PG8_SB(0, 1), cB + hstepB, voffB); PG8_STAGE(PG8_SA(0, 0), cA, voffA); PG8_STAGE(PG8_SA(0, 1), cA + hstepA, voffA);
        if (wr == 1) PG8_BAR;
        PG8_WAIT_V(2); PG8_BAR;
        PG8_STAGE(PG8_SB(1, 0), cB + kstep, voffB); PG8_STAGE(PG8_SA(1, 0), cA + kstep, voffA); PG8_STAGE(PG8_SB(1, 1), cB + hstepB + kstep, voffB);
        PG8_WAIT_V(6); PG8_BAR;
    } else {
        PG8_STAGE(PG8_SB(0, 0), cB, voffB); PG8_STAGE(PG8_SA(0, 0), cA, voffA); PG8_STAGE(PG8_SB(0, 1), cB + hstepB, voffB); PG8_STAGE(PG8_SA(0, 1), cA + hstepA, voffA);
        if (wr == 1) PG8_BAR;
        PG8_WAIT_V(4); PG8_BAR;
        PG8_STAGE(PG8_SB(1, 0), cB + kstep, voffB); PG8_STAGE(PG8_SA(1, 0), cA + kstep, voffA); PG8_STAGE(PG8_SB(1, 1), cB + hstepB + kstep, voffB);
        PG8_WAIT_V(6); PG8_BAR;
    }
    for (;;) {
        const bool has_next = S.next(ui + 1, nxt);
        const char* nA = has_next ? (const char*)g.A + (size_t)nxt.pm * tstepA : cA; const char* nB = has_next ? (const char*)g.Bt + (size_t)nxt.pn * tstepB : cB;
        for (int t = 0; t < nt; t += 2) {
            if constexpr (Hook::ON) { if (t == hook_t) H.apply(acc, cur, wr, fr); }
            const bool last = (t == nt - 2);
            const char* a1 = cA + (size_t)(t + 1) * kstep;
            const char* a2 = last ? nA : cA + (size_t)(t + 2) * kstep; const char* b2 = last ? nB : cB + (size_t)(t + 2) * kstep;
            const char* a3 = a2 + kstep; const char* b3 = b2 + kstep;
            if (last && has_next) S.a_ready(nxt);
            if constexpr (SP2) {
            PG8_LDB(B0, 0, 0); PG8_LDB(B1, 0, 1); PG8_SCHED; PG8_LDA(At, 0, 0); PG8_STAGE(PG8_SA(1, 1), a1 + hstepA, voffA);
            PG8_WAIT_V(8); PG8_WAIT_L(0); PG8_BAR; PG8_MMA(0, 0, At, B0); PG8_MMA(0, 1, At, B1); PG8_BAR; PG8_SCHED;
            PG8_LDA(At, 0, 1); PG8_STAGE(PG8_SB(0, 0), b2, voffB); PG8_STAGE(PG8_SB(0, 1), b2 + hstepB, voffB); PG8_STAGE(PG8_SA(0, 0), a2, voffA);
            PG8_WAIT_V(8); PG8_WAIT_L(0); PG8_BAR; PG8_MMA(1, 0, At, B0); PG8_MMA(1, 1, At, B1); PG8_BAR; PG8_SCHED;
            PG8_LDB(B0, 1, 0); PG8_LDB(B1, 1, 1); PG8_SCHED; PG8_LDA(At, 1, 0); PG8_STAGE(PG8_SA(0, 1), a2 + hstepA, voffA);
            PG8_WAIT_V(8); PG8_WAIT_L(0); PG8_BAR; PG8_MMA(0, 0, At, B0); PG8_MMA(0, 1, At, B1); PG8_BAR; PG8_SCHED;
            PG8_LDA(At, 1, 1); PG8_STAGE(PG8_SB(1, 0), b3, voffB); PG8_STAGE(PG8_SB(1, 1), b3 + hstepB, voffB); PG8_STAGE(PG8_SA(1, 0), a3, voffA);
            PG8_WAIT_V(8); PG8_WAIT_L(0); PG8_BAR; PG8_MMA(1, 0, At, B0); PG8_MMA(1, 1, At, B1); PG8_BAR; PG8_SCHED;
            } else {
            PG8_LDB(B0, 0, 0); PG8_SCHED; PG8_LDA(At, 0, 0); PG8_STAGE(PG8_SA(1, 1), a1 + hstepA, voffA);
            PG8_WAIT_L(8); PG8_BAR; PG8_WAIT_L(0); PG8_MMA(0, 0, At, B0); PG8_BAR; PG8_SCHED;
            PG8_LDB(B1, 0, 1); PG8_STAGE(PG8_SB(0, 0), b2, voffB);
            PG8_BAR; PG8_WAIT_L(0); PG8_MMA(0, 1, At, B1); PG8_BAR;
            PG8_LDA(At, 0, 1); PG8_STAGE(PG8_SA(0, 0), a2, voffA);
            PG8_BAR; PG8_WAIT_L(0); PG8_MMA(1, 0, At, B0); PG8_BAR; PG8_SCHED;
            PG8_STAGE(PG8_SB(0, 1), b2 + hstepB, voffB);
            PG8_WAIT_V(6); PG8_BAR; PG8_MMA(1, 1, At, B1); PG8_BAR;
            PG8_LDB(B0, 1, 0); PG8_SCHED; PG8_LDA(At, 1, 0); PG8_STAGE(PG8_SA(0, 1), a2 + hstepA, voffA);
            PG8_WAIT_L(8); PG8_BAR; PG8_WAIT_L(0); PG8_MMA(0, 0, At, B0); PG8_BAR; PG8_SCHED;
            PG8_LDB(B1, 1, 1); PG8_STAGE(PG8_SB(1, 0), b3, voffB);
            PG8_BAR; PG8_WAIT_L(0); PG8_MMA(0, 1, At, B1); PG8_BAR;
            PG8_LDA(At, 1, 1); PG8_STAGE(PG8_SA(1, 0), a3, voffA);
            PG8_BAR; PG8_WAIT_L(0); PG8_MMA(1, 0, At, B0); PG8_BAR; PG8_SCHED;
            PG8_STAGE(PG8_SB(1, 1), b3 + hstepB, voffB);
            PG8_WAIT_V(6); PG8_BAR; PG8_MMA(1, 1, At, B1); PG8_BAR;
            }
        }
        if constexpr (ALIGN_EPI) { if (wr == 0) PG8_BAR; }
        if constexpr (!Epi::AFTER_DRAIN) { E(acc, cur, wr, wc, fr, fq); S.done(cur); }
        if (!has_next) break;
#pragma unroll
        for (int a = 0; a < 2; ++a)
#pragma unroll
            for (int b = 0; b < 2; ++b)
#pragma unroll
                for (int m = 0; m < 4; ++m)
#pragma unroll
                    for (int n = 0; n < 2; ++n) acc[a][b][m][n] = (f32x4){0.f, 0.f, 0.f, 0.f};
        cur = nxt; cA = nA; cB = nB; ++ui;
        if constexpr (ALIGN_EPI) { if (wr == 1) PG8_BAR; }
    }
    PG8_WAIT_V(0);
    if constexpr (!ALIGN_EPI) { if (wr == 0) PG8_BAR; }
    PG8_BAR;
    if constexpr (Epi::AFTER_DRAIN) { E.fused(acc, cur, wr, wc, fr, fq, lds, wid, lane); S.done(cur); }
#undef PG8_SA
#undef PG8_SB
#undef PG8_STAGE
#undef PG8_LDA
#undef PG8_LDB
#undef PG8_MMA
#undef PG8_WAIT_V
#undef PG8_WAIT_L
#undef PG8_BAR
#undef PG8_SCHED
}
}
#define PG8_UNUSED 0
#define GAS __attribute__((address_space(1)))
#define LAS __attribute__((address_space(3)))
typedef unsigned short bf16;
typedef unsigned v4u __attribute__((ext_vector_type(4)));
typedef float f32x4 __attribute__((ext_vector_type(4)));
typedef short bf16x8 __attribute__((ext_vector_type(8)));
typedef GAS unsigned gu32;
typedef GAS unsigned long long gu64;
#define RLX_AGENT __ATOMIC_RELAXED, __HIP_MEMORY_SCOPE_AGENT
#define LDS_WAIT() asm volatile("s_waitcnt lgkmcnt(0)" ::: "memory")
#define VM_WAIT() asm volatile("s_waitcnt vmcnt(0)" ::: "memory")
__device__ __forceinline__ unsigned long long rt() { return __builtin_amdgcn_s_memrealtime(); }
__device__ __forceinline__ unsigned f2bf(float f) { unsigned u = __builtin_bit_cast(unsigned, f); return (u + 0x7fffu + ((u >> 16) & 1u)) >> 16; }
__device__ __forceinline__ unsigned pk2(float lo, float hi) { return f2bf(lo) | (f2bf(hi) << 16); }

#define XB_TMO      128
#define XB_XCNT(j)  (256  + 64 * (j))
#define XB_XSUB(j)  (1280 + 64 * (j))
#define XB_XGEN(j)  (2304 + 64 * (j))
#define XB_TOP      3328
#define XB_TOPGEN   3392
#define XCD_BAR_WORDS 3456
#define XB_SPIN_CAP (1u << 18)

__device__ __forceinline__ unsigned xb_ld(unsigned* p)              { return __hip_atomic_load(p, __ATOMIC_RELAXED, __HIP_MEMORY_SCOPE_AGENT); }
__device__ __forceinline__ unsigned xb_add(unsigned* p, unsigned v) { return __hip_atomic_fetch_add(p, v, __ATOMIC_RELAXED, __HIP_MEMORY_SCOPE_AGENT); }
__device__ __forceinline__ unsigned xb_xcc_id() { return (unsigned)__builtin_amdgcn_s_getreg((3 << 11) | 20) & 0xFu; }
#define XB_SPIN(cond, bar) do { unsigned _sp = 0; while (cond) { __builtin_amdgcn_s_sleep(1); \
    if ((++_sp & 255u) == 0u) { if (xb_ld(&(bar)[XB_TMO])) break; if (_sp > XB_SPIN_CAP) { atomicAdd(&(bar)[XB_TMO], 1u); break; } } } } while (0)

struct XcdBarrier {
    unsigned* bar; unsigned x; int w;
    volatile LAS unsigned* st;
};

__device__ __forceinline__ XcdBarrier xcd_barrier_post(unsigned* bar, volatile LAS unsigned* st, int wave) {
    XcdBarrier b; b.bar = bar; b.x = xb_xcc_id(); b.st = st; b.w = wave;
    if (wave == 0 && lane_id() == 0) (void)xb_add(&bar[XB_XCNT(b.x)], 1u);
    return b;
}
__device__ __forceinline__ void xcd_barrier_complete(unsigned* bar, unsigned x, unsigned& nloc, unsigned& nx) {
    const unsigned G = gridDim.x * gridDim.y * gridDim.z;
    unsigned sum, cnt, mine, sp = 0u;
    for (;;) {
        sum = 0u; cnt = 0u; mine = 0u;
#pragma unroll
        for (unsigned j = 0; j < 16; ++j) { const unsigned c = xb_ld(&bar[XB_XCNT(j)]); sum += c; cnt += (c > 0u) ? 1u : 0u; mine = (j == x) ? c : mine; }
        if (sum == G) break;
        __builtin_amdgcn_s_sleep(1);
        if ((++sp & 255u) == 0u) { if (xb_ld(&bar[XB_TMO])) break; if (sp > XB_SPIN_CAP) { atomicAdd(&bar[XB_TMO], 1u); break; } }
    }
    nloc = mine > 0u ? mine : 1u; nx = cnt > 0u ? cnt : 1u;
}

__device__ __forceinline__ void xcd_barrier(const XcdBarrier& b) {
    asm volatile("s_waitcnt vmcnt(0)" ::: "memory");
    __syncthreads();
    if (b.w == 0 && lane_id() == 0) {
        unsigned* bar = b.bar;
        __builtin_amdgcn_s_waitcnt(0);
        unsigned nloc = b.st[0], nx = b.st[1];
        if (nloc == 0u) { xcd_barrier_complete(bar, b.x, nloc, nx); b.st[0] = nloc; b.st[1] = nx; }
        const unsigned old = xb_add(&bar[XB_XSUB(b.x)], 1u);
        const unsigned gen = old / nloc;
        if (old + 1u == (gen + 1u) * nloc) {
            __builtin_amdgcn_fence(__ATOMIC_RELEASE, "agent");
            asm volatile("s_waitcnt vmcnt(0)" ::: "memory");
            const unsigned og = xb_add(&bar[XB_TOP], 1u);
            const unsigned tg = og / nx;
            if (og + 1u == (tg + 1u) * nx) xb_add(&bar[XB_TOPGEN], 1u);
            else XB_SPIN(xb_ld(&bar[XB_TOPGEN]) == tg, bar);
            __builtin_amdgcn_fence(__ATOMIC_ACQUIRE, "agent");
            xb_add(&bar[XB_XGEN(b.x)], 1u);
            asm volatile("s_waitcnt vmcnt(0)" ::: "memory");
        } else {
            XB_SPIN(xb_ld(&bar[XB_XGEN(b.x)]) == gen, bar);
            __builtin_amdgcn_fence(__ATOMIC_ACQUIRE, "agent");
            asm volatile("s_waitcnt vmcnt(0)" ::: "memory");
        }
    }
    __syncthreads();
}
constexpr int NWAVES = 8, NTHR = 512;
constexpr size_t MiB = 1u << 20;
constexpr size_t WS_CTL = 0, CTL_ZERO_BYTES = 1 * MiB;
constexpr size_t WS_WIN = 2 * MiB, WS_WGLU = 8 * MiB, WS_WOUT = 10 * MiB;
constexpr size_t WS_XN = 16 * MiB;
constexpr size_t WS_PROJ = 64 * MiB;
constexpr size_t WS_G = 176 * MiB;
constexpr size_t WS_Y2 = 200 * MiB;
constexpr size_t WS_YAR = 240 * MiB, WS_YSR = 280 * MiB;
constexpr size_t WS_UA = 320 * MiB, WS_WSS = 344 * MiB, WS_WYS = 348 * MiB, WS_SL = 354 * MiB;
constexpr size_t WS_XST = 370 * MiB;
constexpr size_t WS_OP = 600 * MiB, WS_ML = 650 * MiB, WS_SPO = 654 * MiB, WS_SPM = 661 * MiB;
constexpr size_t WS_END = 662 * MiB;
constexpr int CW_BAR = 4096;
constexpr int RING_OFF = 0, RING_BYTES = 131072, LDSCTL_OFF = RING_BYTES, MISC_OFF = LDSCTL_OFF + 320, LDS_BYTES = 147456;
constexpr float RMS_EPS = 1e-6f;
constexpr int NPHASE = 8;

typedef float f32x2 __attribute__((ext_vector_type(2)));
typedef unsigned u32x4 __attribute__((ext_vector_type(4)));
__device__ __forceinline__ float bf2f(unsigned short u) { return __uint_as_float(((unsigned)u) << 16); }
__device__ __forceinline__ float bflo(unsigned w) { return __uint_as_float(w << 16); }
__device__ __forceinline__ float bfhi(unsigned w) { return __uint_as_float(w & 0xffff0000u); }
__device__ __forceinline__ float wave_sum(float v) {
#pragma unroll
    for (int o = 1; o < 64; o <<= 1) v += __shfl_xor(v, o);
    return v;
}
__device__ __forceinline__ void sincos_(float x, float& s, float& c) {
    const float k = rintf(x * 0.63661977236758134f);
    float r = fmaf(-k, 1.5703125f, x); r = fmaf(-k, 4.837512969970703125e-4f, r); r = fmaf(-k, 7.54978995489188216e-8f, r);
    const float z = r * r;
    const float sp = r + r * z * (-1.6666654611e-1f + z * (8.3321608736e-3f + z * (-1.9515295891e-4f)));
    const float cp = 1.0f - 0.5f * z + z * z * (4.166664568298827e-2f + z * (-1.388731625493765e-3f + z * 2.443315711809948e-5f));
    const int q = ((int)k) & 3;
    const float ss = (q & 1) ? cp : sp, cc = (q & 1) ? sp : cp;
    s = (q & 2) ? -ss : ss; c = ((q + 1) & 2) ? -cc : cc;
}
__device__ __forceinline__ float gelu_tanh(float x) {
    const float z = 0.7978845608028654f * (x + 0.044715f * x * x * x);
    const float t = __expf(2.0f * z);
    const float th = 1.0f - 2.0f / (t + 1.0f);
    return 0.5f * x * (1.0f + th);
}
__device__ __forceinline__ float silu_(float z) { return z / (1.0f + __expf(-z)); }

struct Args { const float* in[22]; float* out; unsigned char* ws; int ph_lo, ph_hi; };
enum { I_XP = 0, I_XS, I_CK, I_CV, I_SRE, I_SIM, I_GIN, I_WIN, I_ARE, I_AIM, I_LDT, I_BRE, I_BIM, I_CRE, I_CIM, I_D, I_WGLU, I_BGLU, I_GS, I_GA, I_WOUT, I_GF };

__device__ __forceinline__ void p0_transpose_item(const float* W, int K, int N, bf16* WT, LAS float* scr, int k0, int n0, int drow0, int lane) {
#pragma unroll 8
    for (int i = 0; i < 32; ++i) { const int kk = 2 * i + (lane >> 5); scr[kk * 33 + (lane & 31)] = W[(size_t)(k0 + kk) * N + n0 + (lane & 31)]; }
    LDS_WAIT(); asm volatile("" ::: "memory");
    const int c = lane & 7;
#pragma unroll
    for (int j = 0; j < 4; ++j) { const int n = (lane >> 3) + 8 * j; const LAS float* s = scr + (8 * c) * 33 + n;
        v4u o; o.x = pk2(s[0 * 33], s[1 * 33]); o.y = pk2(s[2 * 33], s[3 * 33]); o.z = pk2(s[4 * 33], s[5 * 33]); o.w = pk2(s[6 * 33], s[7 * 33]);
        *(GAS v4u*)(WT + (size_t)(drow0 + n) * K + k0 + 8 * c) = o; }
    LDS_WAIT(); asm volatile("" ::: "memory");
}
__device__ __forceinline__ int glu_perm(int n) { return n < 512 ? (n >> 7) * 256 + (n & 127) : ((n - 512) >> 7) * 256 + 128 + ((n - 512) & 127); }

template <int CTRL> __device__ __forceinline__ float dpp_f(float v) { return __int_as_float(__builtin_amdgcn_update_dpp(0, __float_as_int(v), CTRL, 0xf, 0xf, false)); }
__device__ __forceinline__ float red16(float v) { v += dpp_f<0xB1>(v); v += dpp_f<0x4E>(v); v += dpp_f<0x141>(v); v += dpp_f<0x140>(v); return v; }
__device__ __forceinline__ int lds_take(LAS unsigned* ctr, int lane) { unsigned v = 0u; if (lane == 0) v = __hip_atomic_fetch_add(ctr, 1u, __ATOMIC_RELAXED, __HIP_MEMORY_SCOPE_WORKGROUP); return (int)__builtin_amdgcn_readfirstlane(v); }
__device__ __forceinline__ void cmul(float& xr, float& xi, float ar, float ai) { const float r = xr * ar - xi * ai, i = xr * ai + xi * ar; xr = r; xi = i; }
__device__ __forceinline__ void ssm_disc(const Args& args, int g, int p, float& lr, float& li, float& fre, float& fim) {
    const float dt = expf(args.in[I_LDT][g]), are = args.in[I_ARE][g * 64 + p], aim = args.in[I_AIM][g * 64 + p];
    const float mag = expf(are * dt); float sn, cs; sincos_(aim * dt, sn, cs);
    lr = mag * cs; li = mag * sn; const float den = are * are + aim * aim;
    fre = ((lr - 1.0f) * are + li * aim) / den; fim = (li * are - (lr - 1.0f) * aim) / den;
}
__device__ __forceinline__ void ssm_gen(const Args& args, LAS float* F, bf16* WSs, bf16* WYs, int job, int tid) {
    const int g = job >> 3, part = job & 7;
    LAS float* LR = F; LAS float* LI = F + 1088; LAS float* BR = F + 2176; LAS float* BI = F + 3200; LAS float* KD = F + 4224;
    { const int p = tid & 63;
      const float dt = expf(args.in[I_LDT][g]), are = args.in[I_ARE][g * 64 + p], aim = args.in[I_AIM][g * 64 + p];
      for (int d = tid >> 6; d <= 16; d += 8) { const float mag = expf(are * dt * (float)d); float sn, cs; sincos_(aim * dt * (float)d, sn, cs); LR[d * 64 + p] = mag * cs; LI[d * 64 + p] = mag * sn; }
      if (tid < 64) { float lr, li, fre, fim; ssm_disc(args, g, p, lr, li, fre, fim);
#pragma unroll
          for (int c = 0; c < 16; ++c) { const float br = args.in[I_BRE][(g * 64 + p) * 16 + c], bi = args.in[I_BIM][(g * 64 + p) * 16 + c]; BR[p * 16 + c] = fre * br - fim * bi; BI[p * 16 + c] = fre * bi + fim * br; } }
    }
    __syncthreads();
    for (int e = tid; e < 4096; e += NTHR) { const int d = e >> 8, c = (e >> 4) & 15, c2 = e & 15;
        const float* cre = args.in[I_CRE] + (g * 16 + c) * 64; const float* cim = args.in[I_CIM] + (g * 16 + c) * 64;
        float acc = 0.f;
        for (int p = 0; p < 64; ++p) { const float lr = LR[d * 64 + p], li = LI[d * 64 + p], cr = cre[p], ci = cim[p]; const float xr = cr * lr - ci * li, xi = cr * li + ci * lr; acc += xr * BR[p * 16 + c2] - xi * BI[p * 16 + c2]; }
        if (d == 0 && c == c2) acc += args.in[I_D][g * 16 + c];
        KD[e] = acc; }
    __syncthreads();
    for (int e = tid; e < 32 * 384; e += NTHR) { const int rr = e / 384, k = e % 384, i = 2 * part + (rr >> 4), c = rr & 15; float v;
        if (k < 256) { const int j = k >> 4, c2 = k & 15; v = (j <= i) ? KD[((i - j) << 8) + (c << 4) + c2] : 0.f; }
        else { const int p = (k - 256) & 63; const float lr = LR[(i + 1) * 64 + p], li = LI[(i + 1) * 64 + p], cr = args.in[I_CRE][(g * 16 + c) * 64 + p], ci = args.in[I_CIM][(g * 16 + c) * 64 + p];
            v = (k < 320) ? (cr * lr - ci * li) : -(cr * li + ci * lr); }
        WYs[((size_t)(g * 256 + i * 16 + c)) * 384 + k] = (bf16)f2bf(v); }
    for (int e = tid; e < 16 * 256; e += NTHR) { const int nn = e >> 8, k = e & 255, n = 16 * part + nn, p = n & 63, j = k >> 4, c2 = k & 15;
        const float lr = LR[(15 - j) * 64 + p], li = LI[(15 - j) * 64 + p], br = BR[p * 16 + c2], bi = BI[p * 16 + c2];
        WSs[((size_t)(g * 256 + n)) * 256 + k] = (bf16)f2bf((n < 64) ? (lr * br - li * bi) : (lr * bi + li * br)); }
    for (int e = tid; e < 16 * 32; e += NTHR) *(v4u*)(WSs + ((size_t)(g * 256 + 128 + 16 * part + (e >> 5))) * 256 + 8 * (e & 31)) = (v4u){0u, 0u, 0u, 0u};
    __syncthreads();
}
__device__ __forceinline__ void ssm_carry(const Args& args, const float* SL, bf16* UA, float* out, LAS float* F, int bg, int wave, int lane) {
    const int b = bg >> 5, g = bg & 31, p = lane;
    const float dt = expf(args.in[I_LDT][g]), are = args.in[I_ARE][g * 64 + p], aim = args.in[I_AIM][g * 64 + p];
    float l16r, l16i; { const float mag = expf(are * dt * 16.0f); float sn, cs; sincos_(aim * dt * 16.0f, sn, cs); l16r = mag * cs; l16i = mag * sn; }
    float l256r = l16r, l256i = l16i;
#pragma unroll
    for (int q = 0; q < 4; ++q) cmul(l256r, l256i, l256r, l256i);
    const size_t row0 = (size_t)(g * 1024 + b * 128 + wave * 16);
    const float* slp = SL + row0 * 128 + p;
    float sr[16], si[16];
#pragma unroll
    for (int k = 0; k < 16; ++k) { sr[k] = slp[k * 128]; si[k] = slp[k * 128 + 64]; }
    float tr = 0.f, ti = 0.f;
#pragma unroll
    for (int k = 0; k < 16; ++k) { cmul(tr, ti, l16r, l16i); tr += sr[k]; ti += si[k]; }
    F[wave * 128 + p] = tr; F[wave * 128 + 64 + p] = ti;
    __syncthreads();
    float cr = 0.f, ci = 0.f;
    for (int w = 0; w < wave; ++w) { cmul(cr, ci, l256r, l256i); cr += F[w * 128 + p]; ci += F[w * 128 + 64 + p]; }
    bf16* up = UA + row0 * 384 + 256 + p;
#pragma unroll
    for (int k = 0; k < 16; ++k) { up[k * 384] = (bf16)f2bf(cr); up[k * 384 + 64] = (bf16)f2bf(ci); cmul(cr, ci, l16r, l16i); cr += sr[k]; ci += si[k]; }
    if (wave == 7) { out[O_RP + (b * 32 + g) * 64 + p] = cr; out[O_IP + (b * 32 + g) * 64 + p] = ci; }
    __syncthreads();
}
__device__ __forceinline__ void ssm_sample_item(const Args& args, const bf16* PROJ, bf16* GB, float* out, int it, int lane) {
    const int n = it >> 5, g = it & 31, p = lane;
    float lr, li, fre, fim; ssm_disc(args, g, p, lr, li, fre, fim);
    float bre[16], bim[16], cre[16], cim[16];
#pragma unroll
    for (int c = 0; c < 16; ++c) { const float br = args.in[I_BRE][(g * 64 + p) * 16 + c], bi = args.in[I_BIM][(g * 64 + p) * 16 + c]; bre[c] = fre * br - fim * bi; bim[c] = fre * bi + fim * br;
        cre[c] = args.in[I_CRE][(g * 16 + c) * 64 + p]; cim[c] = args.in[I_CIM][(g * 16 + c) * 64 + p]; }
    float xr = args.in[I_SRE][(n * 32 + g) * 64 + p], xi = args.in[I_SIM][(n * 32 + g) * 64 + p];
    const float dme = (lane < 16) ? args.in[I_D][g * 16 + (lane & 15)] : 0.f;
    for (int j = 0; j < 4; ++j) {
        const size_t row = (size_t)(MP + n * 4 + j);
        const v4u* upp = (const v4u*)(PROJ + row * NPROJ + g * 16);
        const v4u u0 = upp[0], u1 = upp[1];
        const float u[16] = {bflo(u0.x), bfhi(u0.x), bflo(u0.y), bfhi(u0.y), bflo(u0.z), bfhi(u0.z), bflo(u0.w), bfhi(u0.w), bflo(u1.x), bfhi(u1.x), bflo(u1.y), bfhi(u1.y), bflo(u1.z), bfhi(u1.z), bflo(u1.w), bfhi(u1.w)};
        float bur = 0.f, bui = 0.f;
#pragma unroll
        for (int c = 0; c < 16; ++c) { bur = fmaf(bre[c], u[c], bur); bui = fmaf(bim[c], u[c], bui); }
        cmul(xr, xi, lr, li); xr += bur; xi += bui;
        float yme = 0.f, ume = 0.f;
#pragma unroll
        for (int c = 0; c < 16; ++c) { const float rsum = red16(cre[c] * xr - cim[c] * xi);
            const int ri = __float_as_int(rsum);
            const float yc = (__int_as_float(__builtin_amdgcn_readlane(ri, 0)) + __int_as_float(__builtin_amdgcn_readlane(ri, 16))) + (__int_as_float(__builtin_amdgcn_readlane(ri, 32)) + __int_as_float(__builtin_amdgcn_readlane(ri, 48)));
            yme = (lane == c) ? yc : yme; ume = (lane == c) ? u[c] : ume; }
        if (lane < 16) GB[row * 512 + g * 16 + lane] = (bf16)f2bf(gelu_tanh(yme + dme * ume));
    }
    out[O_RS + (n * 32 + g) * 64 + p] = xr; out[O_IS + (n * 32 + g) * 64 + p] = xi;
}
typedef float f32x16 __attribute__((ext_vector_type(16)));
typedef short s16x4 __attribute__((ext_vector_type(4)));
typedef short v4i16_t __attribute__((ext_vector_type(4)));
constexpr float C2LOG = 0.125f * 1.4426950408889634f;
constexpr float M_INIT = -1e30f;
__device__ __forceinline__ int crow(int r, int h2) { return (r & 3) + 8 * (r >> 2) + 4 * h2; }
__device__ __forceinline__ unsigned cvtpk(float lo, float hi) { unsigned r; asm volatile("v_cvt_pk_bf16_f32 %0, %1, %2" : "=v"(r) : "v"(lo), "v"(hi)); return r; }
__device__ __forceinline__ float ex2(float x) { return __builtin_amdgcn_exp2f(x); }

__device__ __forceinline__ float xmax32(float m) { auto rr = __builtin_amdgcn_permlane32_swap(__float_as_uint(m), __float_as_uint(m), false, false); return fmaxf(__uint_as_float(rr[0]), __uint_as_float(rr[1])); }
__device__ __forceinline__ float xsum32(float m) { auto rr = __builtin_amdgcn_permlane32_swap(__float_as_uint(m), __float_as_uint(m), false, false); return __uint_as_float(rr[0]) + __uint_as_float(rr[1]); }
__device__ __forceinline__ void attn_prompt_item(const bf16* __restrict__ PROJ, bf16* __restrict__ OP, f32x2* __restrict__ ML, int item, LAS unsigned char* vst, int lane) {
    const int qb = item & 63, bhp = item >> 6, p = bhp % 3, bh = bhp / 3, h = bh & 7, b = bh >> 3;
    const int dsh = 2 * p, d = 1 << dsh, nbr = 64 >> dsh;
    const int r = qb >> (6 - dsh), jb = qb & (nbr - 1);
    const int q32 = lane & 31, h2 = lane >> 5;
    const int tbase = b * 2048 + r;
    const int mrow = tbase + d * (32 * jb + q32);
    bf16x8 qf[4];
    { const bf16* Qp = PROJ + (size_t)mrow * NPROJ + 1024 + h * 64 + 8 * h2;
#pragma unroll
      for (int s = 0; s < 4; ++s) qf[s] = *(const bf16x8*)(Qp + 16 * s); }
    f32x16 o0, o1;
#pragma unroll
    for (int i = 0; i < 16; ++i) { o0[i] = 0.f; o1[i] = 0.f; }
    float m_run = M_INIT, l_run = 0.f;
    const LAS unsigned char* vrd = vst + (4 * h2 + ((lane & 15) >> 2)) * 128 + (16 * ((lane >> 4) & 1) + 4 * (lane & 3)) * 2;
    LAS unsigned char* vwr = vst + (lane >> 3) * 128 + (lane & 7) * 16;
    const int kb_lo = jb > 4 ? jb - 4 : 0;
    const bf16* Kp0 = PROJ + (size_t)(tbase + d * q32) * NPROJ + 1536 + h * 64 + 8 * h2;
    const bf16* Vp0 = PROJ + (size_t)(tbase + d * (lane >> 3)) * NPROJ + 2048 + h * 64 + 8 * (lane & 7);
    const size_t blk = (size_t)32 * d * NPROJ, v8 = (size_t)8 * d * NPROJ;
    bf16x8 kn[4]; u32x4 vn[4];
#pragma unroll
    for (int s = 0; s < 4; ++s) kn[s] = *(const bf16x8*)(Kp0 + kb_lo * blk + 16 * s);
#pragma unroll
    for (int i = 0; i < 4; ++i) vn[i] = *(const u32x4*)(Vp0 + kb_lo * blk + i * v8);
    for (int kb = kb_lo; kb <= jb; ++kb) {
#pragma unroll
        for (int i = 0; i < 4; ++i) *(LAS u32x4*)(vwr + i * 1024) = vn[i];
        asm volatile("" ::: "memory"); __builtin_amdgcn_wave_barrier();
        s16x4 vlo[4], vhi[4];
#pragma unroll
        for (int s = 0; s < 2; ++s)
#pragma unroll
            for (int mb = 0; mb < 2; ++mb) {
                vlo[2 * s + mb] = __builtin_bit_cast(s16x4, __builtin_amdgcn_ds_read_tr16_b64_v4i16((LAS v4i16_t*)(vrd + s * 2048 + mb * 64)));
                vhi[2 * s + mb] = __builtin_bit_cast(s16x4, __builtin_amdgcn_ds_read_tr16_b64_v4i16((LAS v4i16_t*)(vrd + s * 2048 + 1024 + mb * 64)));
            }
        bf16x8 kf[4];
#pragma unroll
        for (int s = 0; s < 4; ++s) kf[s] = kn[s];
        if (kb < jb) {
#pragma unroll
            for (int s = 0; s < 4; ++s) kn[s] = *(const bf16x8*)(Kp0 + (kb + 1) * blk + 16 * s);
#pragma unroll
            for (int i = 0; i < 4; ++i) vn[i] = *(const u32x4*)(Vp0 + (kb + 1) * blk + i * v8);
        }
        f32x16 st;
#pragma unroll
        for (int i = 0; i < 16; ++i) st[i] = 0.f;
#pragma unroll
        for (int s = 0; s < 4; ++s) st = __builtin_amdgcn_mfma_f32_32x32x16_bf16(kf[s], qf[s], st, 0, 0, 0);
        if (kb == jb || kb + 4 == jb) {
            const int dq = 32 * (jb - kb) + q32 - 4 * h2;
#pragma unroll
            for (int i = 0; i < 16; ++i) { const unsigned dist = (unsigned)(dq - ((i & 3) + 8 * (i >> 2))); st[i] = dist <= 128u ? st[i] : -INFINITY; }
        }
        float mx = fmaxf(fmaxf(st[0], st[1]), fmaxf(st[2], st[3]));
#pragma unroll
        for (int i = 4; i < 16; i += 4) mx = fmaxf(mx, fmaxf(fmaxf(st[i], st[i + 1]), fmaxf(st[i + 2], st[i + 3])));
        mx = xmax32(mx);
        if (__any(mx > m_run)) {
            const float mn = fmaxf(m_run, mx), alpha = ex2((m_run - mn) * C2LOG);
            m_run = mn; l_run *= alpha;
#pragma unroll
            for (int i = 0; i < 16; ++i) { o0[i] *= alpha; o1[i] *= alpha; }
        }
        const float nm = -m_run * C2LOG;
        float ls = 0.f;
#pragma unroll
        for (int i = 0; i < 16; ++i) { st[i] = ex2(fmaf(st[i], C2LOG, nm)); ls += st[i]; }
        l_run += ls;
        bf16x8 pa[2];
#pragma unroll
        for (int s = 0; s < 2; ++s) { u32x4 w; w.x = cvtpk(st[8 * s], st[8 * s + 1]); w.y = cvtpk(st[8 * s + 2], st[8 * s + 3]); w.z = cvtpk(st[8 * s + 4], st[8 * s + 5]); w.w = cvtpk(st[8 * s + 6], st[8 * s + 7]); pa[s] = __builtin_bit_cast(bf16x8, w); }
#pragma unroll
        for (int s = 0; s < 2; ++s) {
            const bf16x8 va0 = (bf16x8){vlo[2 * s][0], vlo[2 * s][1], vlo[2 * s][2], vlo[2 * s][3], vhi[2 * s][0], vhi[2 * s][1], vhi[2 * s][2], vhi[2 * s][3]};
            const bf16x8 va1 = (bf16x8){vlo[2 * s + 1][0], vlo[2 * s + 1][1], vlo[2 * s + 1][2], vlo[2 * s + 1][3], vhi[2 * s + 1][0], vhi[2 * s + 1][1], vhi[2 * s + 1][2], vhi[2 * s + 1][3]};
            o0 = __builtin_amdgcn_mfma_f32_32x32x16_bf16(va0, pa[s], o0, 0, 0, 0);
            o1 = __builtin_amdgcn_mfma_f32_32x32x16_bf16(va1, pa[s], o1, 0, 0, 0);
        }
        asm volatile("" ::: "memory"); __builtin_amdgcn_wave_barrier();
    }
    const float lt = xsum32(l_run), inv = 1.0f / lt;
    bf16* Ob = OP + ((size_t)p * MP + mrow) * 512 + h * 64 + 4 * h2;
#pragma unroll
    for (int g = 0; g < 4; ++g) {
        unsigned long long w0 = (unsigned long long)cvtpk(o0[4 * g] * inv, o0[4 * g + 1] * inv) | ((unsigned long long)cvtpk(o0[4 * g + 2] * inv, o0[4 * g + 3] * inv) << 32);
        unsigned long long w1 = (unsigned long long)cvtpk(o1[4 * g] * inv, o1[4 * g + 1] * inv) | ((unsigned long long)cvtpk(o1[4 * g + 2] * inv, o1[4 * g + 3] * inv) << 32);
        *(unsigned long long*)(Ob + 8 * g) = w0; *(unsigned long long*)(Ob + 32 + 8 * g) = w1;
    }
    if (h2 == 0) ML[((size_t)p * MP + mrow) * 8 + h] = (f32x2){m_run * C2LOG, lt};
}

__device__ __forceinline__ f32x4 bf4_to_f4(const bf16* p) { const unsigned long long w = *(const unsigned long long*)p; return (f32x4){bflo((unsigned)w), bfhi((unsigned)w), bflo((unsigned)(w >> 32)), bfhi((unsigned)(w >> 32))}; }
#define SAMP_UPD(kA, kB, vA, vB, okbits) do { \
    _Pragma("unroll") for (int jq = 0; jq < NQ; ++jq) { \
        _Pragma("unroll") for (int hf = 0; hf < 2; ++hf) { \
            const f32x4 k_ = hf ? (kB) : (kA), v_ = hf ? (vB) : (vA), q_ = q[jq][hf]; \
            float s_ = red16((q_.x * k_.x + q_.y * k_.y) + (q_.z * k_.z + q_.w * k_.w)); \
            s_ = (((okbits) >> jq) & 1u) ? s_ : -INFINITY; \
            const float mn_ = fmaxf(m[jq][hf], s_), al_ = ex2(m[jq][hf] - mn_), pe_ = ex2(s_ - mn_); \
            m[jq][hf] = mn_; l[jq][hf] = l[jq][hf] * al_ + pe_; o[jq][hf] = o[jq][hf] * al_ + v_ * pe_; } } } while (0)
template <int NQ, bool DENSE> __device__ __forceinline__ void samp_run(const bf16* __restrict__ PROJ, const float* __restrict__ ck, const float* __restrict__ cv, float* SPO, f32x2* SPM,
                                                                         int n, int j0, int slot, int r0, int stride, int nlo, int nhi, int lane) {
    f32x4 q[NQ][2], o[NQ][2]; float m[NQ][2], l[NQ][2];
#pragma unroll
    for (int jq = 0; jq < NQ; ++jq) {
        const bf16* qp = PROJ + (size_t)(MP + n * 4 + j0 + jq) * NPROJ + 1024 + 4 * lane;
        q[jq][0] = bf4_to_f4(qp) * C2LOG; q[jq][1] = bf4_to_f4(qp + 256) * C2LOG;
#pragma unroll
        for (int hf = 0; hf < 2; ++hf) { o[jq][hf] = (f32x4){0.f, 0.f, 0.f, 0.f}; m[jq][hf] = M_INIT; l[jq][hf] = 0.f; }
    }
    constexpr int PF = DENSE ? 2 : 8;
    f32x4 pf[PF][4];
    const float* ckp = ck + (size_t)r0 * 512; const float* cvp = cv + (size_t)r0 * 512; const size_t rstep = (size_t)stride * 512;
#pragma unroll
    for (int sl = 0; sl < PF; ++sl) {
        pf[sl][0] = __builtin_nontemporal_load((const f32x4*)(ckp)); pf[sl][1] = __builtin_nontemporal_load((const f32x4*)(ckp + 256));
        pf[sl][2] = __builtin_nontemporal_load((const f32x4*)(cvp)); pf[sl][3] = __builtin_nontemporal_load((const f32x4*)(cvp + 256)); ckp += rstep; cvp += rstep; }
    for (int i = 0; i < 64; i += PF) {
#pragma unroll
        for (int sl = 0; sl < PF; ++sl) {
            const int row = r0 + stride * (i + sl);
            unsigned okb = 0xFu;
            if (DENSE) okb = 1u | (row >= 1921 ? 2u : 0u) | (row >= 1922 ? 4u : 0u) | (row >= 1923 ? 8u : 0u);
            SAMP_UPD(pf[sl][0], pf[sl][1], pf[sl][2], pf[sl][3], okb);
            if (i + PF < 64) {
                pf[sl][0] = __builtin_nontemporal_load((const f32x4*)(ckp)); pf[sl][1] = __builtin_nontemporal_load((const f32x4*)(ckp + 256));
                pf[sl][2] = __builtin_nontemporal_load((const f32x4*)(cvp)); pf[sl][3] = __builtin_nontemporal_load((const f32x4*)(cvp + 256)); ckp += rstep; cvp += rstep; }
        }
    }
    for (int rn = nlo; rn < nhi; ++rn) {
        const bf16* rp = PROJ + (size_t)(MP + n * 4 + rn) * NPROJ + 4 * lane;
        const f32x4 kA = bf4_to_f4(rp + 1536), kB = bf4_to_f4(rp + 1536 + 256), vA = bf4_to_f4(rp + 2048), vB = bf4_to_f4(rp + 2048 + 256);
        unsigned okb = 0xFu;
        if (DENSE) okb = (rn <= 0 ? 1u : 0u) | (rn <= 1 ? 2u : 0u) | (rn <= 2 ? 4u : 0u) | 8u;
        SAMP_UPD(kA, kB, vA, vB, okb);
    }
#pragma unroll
    for (int jq = 0; jq < NQ; ++jq) {
        const size_t rec = ((size_t)(n * 4 + j0 + jq) * 6 + slot);
#pragma unroll
        for (int hf = 0; hf < 2; ++hf) {
            *(f32x4*)(SPO + rec * 512 + hf * 256 + 4 * lane) = o[jq][hf];
            if ((lane & 15) == 0) { f32x2 t; t.x = m[jq][hf]; t.y = l[jq][hf]; SPM[rec * 8 + hf * 4 + (lane >> 4)] = t; }
        }
    }
}
__device__ __forceinline__ void attn_sample_item(const bf16* __restrict__ PROJ, const float* __restrict__ CK, const float* __restrict__ CV, float* SPO, f32x2* SPM, int si, int lane) {
    const int n = si / 18, k = si % 18;
    const float* ck = CK + (size_t)n * 2048 * 512 + 4 * lane; const float* cv = CV + (size_t)n * 2048 * 512 + 4 * lane;
    if (k < 2) {
        samp_run<4, true>(PROJ, ck, cv, SPO, SPM, n, 0, k, 1920 + 64 * k, 1, 0, k ? 4 : 0, lane);
    } else {
        const int kk = k - 2, pat = kk >> 3, j = (kk & 7) >> 1, hf2 = kk & 1;
        const int stride = pat ? 16 : 4, r0 = (pat ? j : 1536 + j) + stride * 64 * hf2;
        samp_run<1, false>(PROJ, ck, cv, SPO, SPM, n, j, 2 + 2 * pat + hf2, r0, stride, j, hf2 ? j + 1 : j, lane);
    }
}
__device__ __forceinline__ void attn_combine_row(const bf16* __restrict__ PROJ, const bf16* __restrict__ OP, const f32x2* __restrict__ ML, const float* __restrict__ SPO, const f32x2* __restrict__ SPM,
                                                 const float* __restrict__ ga, bf16* __restrict__ Y2, int m, int lane) {
    const int hd = lane >> 3;
    float acc[8];
    if (m < MP) {
        f32x2 ml[3]; float bm = M_INIT;
#pragma unroll
        for (int p = 0; p < 3; ++p) { ml[p] = ML[((size_t)p * MP + m) * 8 + hd]; bm = fmaxf(bm, ml[p].x); }
        float w[3], den = 0.f;
#pragma unroll
        for (int p = 0; p < 3; ++p) { w[p] = ex2(ml[p].x - bm) * ml[p].y; den += w[p]; }
        const float inv = 1.0f / den;
#pragma unroll
        for (int i = 0; i < 8; ++i) acc[i] = 0.f;
#pragma unroll
        for (int p = 0; p < 3; ++p) { const u32x4 v = *(const u32x4*)(OP + ((size_t)p * MP + m) * 512 + 8 * lane); const float ww = w[p] * inv;
            acc[0] += ww * bflo(v.x); acc[1] += ww * bfhi(v.x); acc[2] += ww * bflo(v.y); acc[3] += ww * bfhi(v.y); acc[4] += ww * bflo(v.z); acc[5] += ww * bfhi(v.z); acc[6] += ww * bflo(v.w); acc[7] += ww * bfhi(v.w); }
    } else {
        const size_t rec0 = (size_t)(m - MP) * 6;
        f32x2 ml[6]; float bm = M_INIT;
#pragma unroll
        for (int s = 0; s < 6; ++s) { ml[s] = SPM[(rec0 + s) * 8 + hd]; bm = fmaxf(bm, ml[s].x); }
        float w[6], den = 0.f;
#pragma unroll
        for (int s = 0; s < 6; ++s) { w[s] = ex2(ml[s].x - bm); den += w[s] * ml[s].y; }
        const float inv = 1.0f / den;
#pragma unroll
        for (int i = 0; i < 8; ++i) acc[i] = 0.f;
#pragma unroll
        for (int s = 0; s < 6; ++s) { const f32x4 a = *(const f32x4*)(SPO + (rec0 + s) * 512 + 8 * lane), b = *(const f32x4*)(SPO + (rec0 + s) * 512 + 8 * lane + 4); const float ww = w[s] * inv;
            acc[0] += ww * a.x; acc[1] += ww * a.y; acc[2] += ww * a.z; acc[3] += ww * a.w; acc[4] += ww * b.x; acc[5] += ww * b.y; acc[6] += ww * b.z; acc[7] += ww * b.w; }
    }
    const u32x4 zw = *(const u32x4*)(PROJ + (size_t)m * NPROJ + 2560 + 8 * lane);
    const float z[8] = {bflo(zw.x), bfhi(zw.x), bflo(zw.y), bfhi(zw.y), bflo(zw.z), bfhi(zw.z), bflo(zw.w), bfhi(zw.w)};
    float ss = 0.f;
#pragma unroll
    for (int i = 0; i < 8; ++i) { acc[i] *= silu_(z[i]); ss += acc[i] * acc[i]; }
    const float rs = 1.0f / sqrtf(wave_sum(ss) * (1.f / 512) + RMS_EPS);
    const f32x4 g0 = *(const f32x4*)(ga + 8 * lane), g1 = *(const f32x4*)(ga + 8 * lane + 4);
    u32x4 o; o.x = pk2(acc[0] * rs * g0.x, acc[1] * rs * g0.y); o.y = pk2(acc[2] * rs * g0.z, acc[3] * rs * g0.w); o.z = pk2(acc[4] * rs * g1.x, acc[5] * rs * g1.y); o.w = pk2(acc[6] * rs * g1.z, acc[7] * rs * g1.w);
    *(u32x4*)(Y2 + (size_t)m * DM + 512 + 8 * lane) = o;
}

__device__ __forceinline__ void final_norm_rows(float* out, const float* gf, int m0, int m1, int gw, int NGW, int lane) {
    for (int m = m0 + gw; m < m1; m += NGW) {
        GAS f32x4* yr = (GAS f32x4*)(out + O_YP + (size_t)m * DM) + lane;
        f32x4 v[4]; float s = 0.f;
#pragma unroll
        for (int j = 0; j < 4; ++j) { v[j] = yr[64 * j]; s += (v[j].x * v[j].x + v[j].y * v[j].y) + (v[j].z * v[j].z + v[j].w * v[j].w); }
        const float rs = 1.0f / sqrtf(wave_sum(s) * (1.f / DM) + RMS_EPS);
#pragma unroll
        for (int j = 0; j < 4; ++j) { const f32x4 g4 = *((const f32x4*)gf + lane + 64 * j); yr[64 * j] = v[j] * rs * g4; }
    }
}
__device__ __forceinline__ void branch_norm(const float* src, const float* gg, bf16* Y2, int coff, int gw, int NGW, int lane) {
    for (int m = gw; m < MT; m += NGW) {
        const f32x4 a = *((const f32x4*)(src + (size_t)m * 512) + lane), b = *((const f32x4*)(src + (size_t)m * 512) + 64 + lane);
        const float s = (a.x * a.x + a.y * a.y) + (a.z * a.z + a.w * a.w) + (b.x * b.x + b.y * b.y) + (b.z * b.z + b.w * b.w);
        const float rs = 1.0f / sqrtf(wave_sum(s) * (1.f / 512) + RMS_EPS);
        const f32x4 g0 = *((const f32x4*)gg + lane), g1 = *((const f32x4*)gg + 64 + lane);
        unsigned long long* o8 = (unsigned long long*)(Y2 + (size_t)m * DM + coff);
        o8[lane] = (unsigned long long)pk2(a.x * rs * g0.x, a.y * rs * g0.y) | ((unsigned long long)pk2(a.z * rs * g0.z, a.w * rs * g0.w) << 32);
        o8[64 + lane] = (unsigned long long)pk2(b.x * rs * g1.x, b.y * rs * g1.y) | ((unsigned long long)pk2(b.z * rs * g1.z, b.w * rs * g1.w) << 32);
    }
}

__global__ void __launch_bounds__(NTHR, 2) fwd(Args args) {
    extern __shared__ __attribute__((aligned(16))) unsigned char lds[];
    LAS unsigned char* L = (LAS unsigned char*)lds;
    const int wave = __builtin_amdgcn_readfirstlane(threadIdx.x >> 6);
    const int G = gridDim.x, gw = blockIdx.x * NWAVES + wave, NGW = G * NWAVES;
#define LANE_TID const int lane = lane_id(), tid = wave * 64 + lane; (void)tid
    unsigned char* ws = args.ws; float* out = args.out;
    bf16* Win_t = (bf16*)(ws + WS_WIN); bf16* Wglu_t = (bf16*)(ws + WS_WGLU); bf16* Wout_t = (bf16*)(ws + WS_WOUT);
    bf16* XN = (bf16*)(ws + WS_XN); bf16* PROJ = (bf16*)(ws + WS_PROJ); bf16* GB = (bf16*)(ws + WS_G); bf16* Y2 = (bf16*)(ws + WS_Y2);
    bf16* OP = (bf16*)(ws + WS_OP); f32x2* ML = (f32x2*)(ws + WS_ML); float* SPO = (float*)(ws + WS_SPO); f32x2* SPM = (f32x2*)(ws + WS_SPM);
    float* YAR = (float*)(ws + WS_YAR); float* YSR = (float*)(ws + WS_YSR); bf16* UA = (bf16*)(ws + WS_UA); bf16* WSs = (bf16*)(ws + WS_WSS); bf16* WYs = (bf16*)(ws + WS_WYS); float* SL = (float*)(ws + WS_SL);
    float* rowss = (float*)(ws + WS_CTL + 262144);
    const int lo = args.ph_lo, hi = args.ph_hi;
#define IN(k) (lo <= (k) && (k) < hi)
#ifndef PROBE_DUP
#define PROBE_DUP 0
#endif
#define DUP(k, ...) do { { __VA_ARGS__ } if (PROBE_DUP == (k)) { __syncthreads(); { __VA_ARGS__ } } } while (0)
#define SEAM(k) do { if (IN(k) && IN((k) + 1)) xcd_barrier(bar); } while (0)
    gu32* ctl = (gu32*)(ws + WS_CTL);
    { LANE_TID; for (int u = tid; u < (LDS_BYTES - LDSCTL_OFF) / 4; u += NTHR) ((LAS unsigned*)(L + LDSCTL_OFF))[u] = 0u; }
    __syncthreads();
    XcdBarrier bar; bar.bar = (unsigned*)(ctl + CW_BAR); bar.x = 0; bar.st = nullptr; bar.w = wave;
    if (hi - lo > 1) bar = xcd_barrier_post((unsigned*)(ctl + CW_BAR), (volatile LAS unsigned*)(L + MISC_OFF) + 8, wave);

    if (IN(0)) {
        LANE_TID;
        DUP(1,

        for (int job = blockIdx.x; job < 256; job += G) ssm_gen(args, (LAS float*)(L + RING_OFF), WSs, WYs, job, tid);
        LAS float* scr = (LAS float*)(L + RING_OFF + wave * 16384);
        constexpr int I_A = 16 * 96, I_B = 8 * 32, I_C = 16 * 32;
        for (int it = gw; it < I_A + I_B + I_C; it += NGW) {
            int r = it;
            if (r < I_A) { const int kb = r / 96, nb = r % 96; p0_transpose_item(args.in[I_WIN], 1024, 3072, Win_t, scr, 64 * kb, 32 * nb, 32 * nb, lane); continue; } r -= I_A;
            if (r < I_B) { const int kb = r / 32, nb = r % 32; p0_transpose_item(args.in[I_WGLU], 512, 1024, Wglu_t, scr, 64 * kb, 32 * nb, glu_perm(32 * nb), lane); continue; } r -= I_B;
            { const int kb = r / 32, nb = r % 32; p0_transpose_item(args.in[I_WOUT], 1024, 1024, Wout_t, scr, 64 * kb, 32 * nb, 32 * nb, lane); }
        }
        const float* gin = args.in[I_GIN];
        for (int m = gw; m < MT; m += NGW) {
            const float* xrow = (m < MP) ? args.in[I_XP] + (size_t)m * DM : args.in[I_XS] + (size_t)(m - MP) * DM;
            const GAS f32x4* xr = (const GAS f32x4*)xrow + lane;
            f32x4 v[4]; float s = 0.f;
_Pragma("unroll")
            for (int j = 0; j < 4; ++j) { v[j] = xr[64 * j]; s += (v[j].x * v[j].x + v[j].y * v[j].y) + (v[j].z * v[j].z + v[j].w * v[j].w); }
            const float rs = 1.0f / sqrtf(wave_sum(s) * (1.f / DM) + RMS_EPS);
            GAS unsigned long long* o8 = (GAS unsigned long long*)(XN + (size_t)m * DM) + lane;
_Pragma("unroll")
            for (int j = 0; j < 4; ++j) { const f32x4 g4 = *((const f32x4*)gin + lane + 64 * j);
                o8[64 * j] = (unsigned long long)pk2(v[j].x * rs * g4.x, v[j].y * rs * g4.y) | ((unsigned long long)pk2(v[j].z * rs * g4.z, v[j].w * rs * g4.w) << 32); }
        }
        );
    }
    SEAM(0);
    if (IN(1)) {
        DUP(2, { pg8::Gemm g{XN, Win_t, MP, NPROJ, DM, DM, DM}; pg8::StaticOrder S; S.init(MP, NPROJ, G, (int)blockIdx.x);
          pg8::EpiProj E{PROJ, out, UA, 0};
          pg8::gemm_phase<pg8::EpiProj, pg8::StaticOrder, true, true>(L + RING_OFF, g, S, E, wave); }
        { pg8::Gemm g{XN + (size_t)MP * DM, Win_t, MS, NPROJ, DM, DM, DM}; pg8::SmallOrder S{0, 12, 24, (int)blockIdx.x};
          pg8::EpiProj E{PROJ, out, UA, 64};
          pg8::gemm_phase<pg8::EpiProj, pg8::SmallOrder, true, true>(L + RING_OFF, g, S, E, wave); } );
    }
    SEAM(1);
    if (IN(2)) {
        LANE_TID;
        DUP(3, pg8::Gemm g{UA, WSs, 32768, 8192, 256, 384, 256}; pg8::SsmOrder S{G, (int)blockIdx.x}; pg8::EpiSsmS E{SL};
          pg8::gemm_phase<pg8::EpiSsmS, pg8::SsmOrder, true, true>(L + RING_OFF, g, S, E, wave); );
        LAS unsigned* wq = (LAS unsigned*)(L + LDSCTL_OFF);
        const int s_lo = (int)(((long)2304 * blockIdx.x) / G), s_n = (int)(((long)2304 * (blockIdx.x + 1)) / G) - s_lo;
        const int m_lo = (int)(((long)4096 * blockIdx.x) / G), m_n = (int)(((long)4096 * (blockIdx.x + 1)) / G) - m_lo;
        const int u_lo = (int)(((long)1536 * blockIdx.x) / G), u_n = ((int)(((long)1536 * (blockIdx.x + 1)) / G) - u_lo) * 8;
        const int c_n = m_n + u_n;
#define RUN_STREAM() do { for (;;) { const int idx = lds_take(wq + 0, lane); if (idx >= s_n) break; const int ln = lane_id(); attn_sample_item(PROJ, args.in[I_CK], args.in[I_CV], SPO, SPM, s_lo + idx, ln); } } while (0)
#define RUN_COMPUTE() do { for (;;) { const int idx = lds_take(wq + 1, lane); if (idx >= c_n) break; const int ln = lane_id(); \
            if (idx < m_n) ssm_sample_item(args, PROJ, GB, out, m_lo + idx, ln); else attn_prompt_item(PROJ, OP, ML, u_lo * 8 + (idx - m_n), L + RING_OFF + wave * 4096, ln); } } while (0)
        RUN_STREAM(); RUN_COMPUTE();
        if (PROBE_DUP == 21) { __syncthreads(); if (wave == 0 && lane == 0) { wq[0] = 0u; wq[1] = 0u; } __syncthreads(); RUN_STREAM(); }
        if (PROBE_DUP == 22) { __syncthreads(); if (wave == 0 && lane == 0) { wq[0] = 0u; wq[1] = 0u; } __syncthreads(); RUN_COMPUTE(); }
#undef RUN_STREAM
#undef RUN_COMPUTE
    }
    SEAM(2);
    if (IN(3)) {
        LANE_TID;
        { pg8::Gemm g{GB + (size_t)MP * 512, Wglu_t, MS, 1024, 512, 512, 512}; pg8::SmallOrder S{G - 8, 4, 8, (int)blockIdx.x};
          pg8::EpiGlu E{PROJ, args.in[I_BGLU], args.in[I_GS], Y2, rowss, 64};
          pg8::gemm_phase<pg8::EpiGlu, pg8::SmallOrder, true, true>(L + RING_OFF, g, S, E, wave); }
        DUP(7, for (int bg = blockIdx.x; bg < 256; bg += G) ssm_carry(args, SL, UA, out, (LAS float*)(L + RING_OFF), bg, wave, lane); );
        DUP(8, for (int m = gw; m < MT; m += NGW) attn_combine_row(PROJ, OP, ML, SPO, SPM, args.in[I_GA], Y2, m, lane); );
    }
    SEAM(3);
    if (IN(4)) {
        DUP(9, pg8::Gemm g{UA, WYs, 32768, 8192, 384, 384, 384}; pg8::SsmOrder S{G, (int)blockIdx.x}; pg8::EpiSsmY E{GB};
          pg8::gemm_phase<pg8::EpiSsmY, pg8::SsmOrder, true, true>(L + RING_OFF, g, S, E, wave); );
        { pg8::Gemm g{Y2 + (size_t)MP * DM, Wout_t, MS, DM, DM, DM, DM}; pg8::SmallOrder S{G - 8, 4, 8, (int)blockIdx.x};
          pg8::EpiOut E{args.in[I_XP], args.in[I_XS], out, 64}; pg8::RowScaleHook H{rowss, MP};
          pg8::gemm_phase<pg8::EpiOut, pg8::SmallOrder, true, true, pg8::RowScaleHook>(L + RING_OFF, g, S, E, wave, H, 8); }
    }
    SEAM(4);
    if (IN(5)) {
        DUP(10, pg8::Gemm g{GB, Wglu_t, MP, 1024, 512, 512, 512}; pg8::StaticOrder S; S.init(MP, 1024, G, (int)blockIdx.x);
          pg8::EpiGlu E{PROJ, args.in[I_BGLU], args.in[I_GS], Y2, rowss, 0};
          pg8::gemm_phase<pg8::EpiGlu, pg8::StaticOrder, true, true>(L + RING_OFF, g, S, E, wave); );
        { LANE_TID; final_norm_rows(out, args.in[I_GF], MP, MT, gw, NGW, lane); }
    }
    SEAM(5);
    if (IN(6)) {
        DUP(12, pg8::Gemm g{Y2, Wout_t, MP, DM, DM, DM, DM}; pg8::StaticOrder S; S.init(MP, DM, G, (int)blockIdx.x);
          pg8::EpiOut E{args.in[I_XP], args.in[I_XS], out, 0}; pg8::RowScaleHook H{rowss, 0};
          pg8::gemm_phase<pg8::EpiOut, pg8::StaticOrder, true, true, pg8::RowScaleHook>(L + RING_OFF, g, S, E, wave, H, 8); );
    }
    SEAM(6);
    if (IN(7)) { LANE_TID; final_norm_rows(out, args.in[I_GF], 0, MP, gw, NGW, lane); }
#undef IN
#undef SEAM
#undef LANE_TID
#undef DUP
}

extern "C" void kernel_launch(void* const* d_in, const int* in_sizes, int n_in, void* d_out, int out_size, void* d_ws, size_t ws_size, hipStream_t stream) {
    static int grid = 0;
    if (grid == 0) {
        if (n_in != 22 || out_size != (int)O_END || ws_size < WS_END) { fprintf(stderr, "kernel_launch: unexpected shapes n_in %d out %d ws %zu\n", n_in, out_size, ws_size); grid = -1; return; }
        int dev = 0, cus = 0, per_cu = 0;
        if (hipGetDevice(&dev) != hipSuccess || hipDeviceGetAttribute(&cus, hipDeviceAttributeMultiprocessorCount, dev) != hipSuccess) { grid = -1; return; }
        if (hipFuncSetAttribute((const void*)fwd, hipFuncAttributeMaxDynamicSharedMemorySize, LDS_BYTES) != hipSuccess) { fprintf(stderr, "kernel_launch: hipFuncSetAttribute failed\n"); grid = -1; return; }
        if (hipOccupancyMaxActiveBlocksPerMultiprocessor(&per_cu, (const void*)fwd, NTHR, LDS_BYTES) != hipSuccess || per_cu < 1) fprintf(stderr, "kernel_launch: occupancy query says %d\n", per_cu);
        (void)hipGetLastError();
        grid = cus;
    }
    if (grid < 0) return;
    (void)hipMemsetAsync((char*)d_ws + WS_CTL, 0, CTL_ZERO_BYTES, stream);
    Args a{};
    for (int i = 0; i < 22; ++i) a.in[i] = (const float*)d_in[i];
    a.out = (float*)d_out; a.ws = (unsigned char*)d_ws;
#if defined(MK_PER_PHASE)
    for (int ph = 0; ph < NPHASE; ++ph) { a.ph_lo = ph; a.ph_hi = ph + 1; hipLaunchKernelGGL(fwd, dim3(grid), dim3(NTHR), LDS_BYTES, stream, a); }
#else
    a.ph_lo = 0; a.ph_hi = NPHASE;
    hipLaunchKernelGGL(fwd, dim3(grid), dim3(NTHR), LDS_BYTES, stream, a);
#endif
}
```
